# Optimizing an MI355X kernel written in HIP

```python
import jax, jax.numpy as jnp
from jax import lax
import numpy as np

D_MODEL = 1024
BATCH = 16
SEQ = 2048
DEPTH = 4

N_MIXERS = 2
N_RET_LAYERS = (DEPTH + 1) // 2
N_NSA_LAYERS = DEPTH // 2

D_FF = 2816
RMS_EPS = 1e-6

RET_HEADS = 4
RET_DK = D_MODEL // RET_HEADS
RET_DV = 2 * RET_DK
RET_CHUNK = 128
RET_ROPE_BASE = 10000.0
RET_IN = RET_HEADS * (2 * RET_DK + 2 * RET_DV)

NSA_HEADS = 16
NSA_GROUPS = 4
NSA_HPG = NSA_HEADS // NSA_GROUPS
NSA_DH = 64
NSA_KV = NSA_GROUPS * NSA_DH
CMP_LEN = 32
CMP_STRIDE = 16
CMP_HID = 256
SLC_LEN = 64
N_SEL = 8
WINDOW = 512
NSA_QBLOCK = 32
NSA_IN = NSA_HEADS * NSA_DH + 6 * NSA_KV + 3 * NSA_HEADS

NUM_BUCKETS = 32
MAX_DISTANCE = 128

NEG_INF = -1e30
SEL_BIG = 1e9

kernel_name = "hybrid_retention_nsa_macaron"


def rmsnorm(x, g):
    xf = x.astype(jnp.float32)
    y = xf * lax.rsqrt(jnp.mean(xf * xf, axis=-1, keepdims=True) + RMS_EPS)
    return (y * g.astype(jnp.float32)).astype(x.dtype)


def headnorm(a, g):
    af = a.astype(jnp.float32)
    return af * lax.rsqrt(jnp.mean(af * af, axis=-1, keepdims=True) + RMS_EPS) * g.astype(jnp.float32)


def swiglu_ffn(x, norm_g, w_gu, w_down):
    h = rmsnorm(x, norm_g) @ w_gu
    a, b = jnp.split(h, 2, axis=-1)
    return (jax.nn.silu(a) * b) @ w_down


def t5_bucket(dist):
    n = jnp.maximum(dist, 0)
    max_exact = NUM_BUCKETS // 2
    nf = jnp.maximum(n, max_exact).astype(jnp.float32)
    large = max_exact + (jnp.log(nf / max_exact) / np.float32(np.log(MAX_DISTANCE / max_exact))
                         * (NUM_BUCKETS - max_exact)).astype(jnp.int32)
    large = jnp.minimum(large, NUM_BUCKETS - 1)
    return jnp.where(n < max_exact, n, large)


def rotary(x, pos):
    half = x.shape[-1] // 2
    inv_freq = RET_ROPE_BASE ** (-jnp.arange(half, dtype=jnp.float32) / half)
    ang = pos[:, None] * inv_freq[None, :]
    cos, sin = jnp.cos(ang), jnp.sin(ang)
    x1, x2 = x[..., :half], x[..., half:]
    return jnp.concatenate([x1 * cos - x2 * sin, x1 * sin + x2 * cos], axis=-1)


def retention(xn, w_in, w_out):
    B, T, _ = xn.shape
    H, dk, dv, C = RET_HEADS, RET_DK, RET_DV, RET_CHUNK
    N = T // C
    h = xn @ w_in
    q, k, v, g = jnp.split(h, [H * dk, 2 * H * dk, 2 * H * dk + H * dv], axis=-1)
    q = q.reshape(B, T, H, dk).transpose(0, 2, 1, 3).astype(jnp.float32)
    k = k.reshape(B, T, H, dk).transpose(0, 2, 1, 3).astype(jnp.float32)
    v = v.reshape(B, T, H, dv).transpose(0, 2, 1, 3).astype(jnp.float32)
    pos = jnp.arange(T, dtype=jnp.float32)
    q = rotary(q, pos)
    k = rotary(k, pos) * (dk ** -0.5)
    log_gamma = jnp.log(1.0 - 2.0 ** (-5.0 - jnp.arange(H, dtype=jnp.float32)))
    i = jnp.arange(C)
    diff = i[:, None] - i[None, :]
    intra = jnp.where(diff >= 0, jnp.exp(log_gamma[:, None, None] * jnp.maximum(diff, 0)), 0.0)
    q_dec = jnp.exp(log_gamma[:, None] * (i + 1))[:, :, None]
    k_dec = jnp.exp(log_gamma[:, None] * (C - 1 - i))[:, :, None]
    chunk_dec = jnp.exp(log_gamma * C)[:, None, None]

    def to_chunks(a):
        return a.reshape(B, H, N, C, a.shape[-1]).transpose(2, 0, 1, 3, 4)

    def step(S, qkv):
        qc, kc, vc = qkv
        s = jnp.einsum('bhid,bhjd->bhij', qc, kc) * intra
        o = (jnp.einsum('bhij,bhjv->bhiv', s, vc)
             + jnp.einsum('bhid,bhdv->bhiv', qc * q_dec, S))
        S = chunk_dec * S + jnp.einsum('bhjd,bhjv->bhdv', kc * k_dec, vc)
        return S, o

    S0 = jnp.zeros((B, H, dk, dv), jnp.float32)
    _, o = lax.scan(step, S0, (to_chunks(q), to_chunks(k), to_chunks(v)))
    o = o.transpose(1, 2, 0, 3, 4).reshape(B, H, T, dv)
    o = o * lax.rsqrt(jnp.mean(o * o, axis=-1, keepdims=True) + RMS_EPS)
    o = o.transpose(0, 2, 1, 3).reshape(B, T, H * dv)
    o = jax.nn.silu(g.astype(jnp.float32)) * o
    return o.astype(xn.dtype) @ w_out


def masked_softmax(s, valid):
    p = jax.nn.softmax(jnp.where(valid, s, NEG_INF), axis=-1)
    return jnp.where(valid, p, 0.0)


def nsa(xn, w_in, w_out, q_gain, k_gain, cmp_pos, cmp_w1, cmp_w2, rel_bias):
    B, T, _ = xn.shape
    H, G, P, dh, QB = NSA_HEADS, NSA_GROUPS, NSA_HPG, NSA_DH, NSA_QBLOCK
    n_cmp = (T - CMP_LEN) // CMP_STRIDE + 1
    n_slc = T // SLC_LEN
    n_sel = min(N_SEL, n_slc)
    sizes = [H * dh] + [NSA_KV] * 6 + [3 * H]
    parts = jnp.split(xn @ w_in, list(np.cumsum(sizes)[:-1]), axis=-1)
    q_, kc_, vc_, ks_, vs_, kw_, vw_, gate_ = parts

    def heads(a, n):
        return a.reshape(B, T, n, dh).transpose(0, 2, 1, 3)

    q = headnorm(heads(q_, H), q_gain).reshape(B, G, P, T, dh)
    cidx = np.arange(n_cmp)[:, None] * CMP_STRIDE + np.arange(CMP_LEN)[None, :]

    def compress(a, j):
        blocks = a[:, :, cidx] + cmp_pos[j]
        flat = blocks.reshape(B, G, n_cmp, CMP_LEN * dh)
        return jax.nn.gelu(flat @ cmp_w1[j]) @ cmp_w2[j]

    k_cmp = headnorm(compress(heads(kc_, G), 0), k_gain[0])
    v_cmp = compress(heads(vc_, G), 1)
    k_slc = headnorm(heads(ks_, G), k_gain[1]).reshape(B, G, n_slc, SLC_LEN, dh)
    v_slc = heads(vs_, G).reshape(B, G, n_slc, SLC_LEN, dh)
    pad = ((0, 0), (0, 0), (WINDOW, 0), (0, 0))
    k_win = jnp.pad(headnorm(heads(kw_, G), k_gain[2]), pad)
    v_win = jnp.pad(heads(vw_, G), pad)
    gates = jax.nn.sigmoid(gate_.astype(jnp.float32)).reshape(B, T, 3, G, P).transpose(0, 2, 3, 4, 1)

    ci = np.arange(n_cmp) * CMP_STRIDE
    sj = np.arange(n_slc) * SLC_LEN
    overlap = jnp.asarray(((ci[:, None] < sj[None, :] + SLC_LEN) &
                           (ci[:, None] + CMP_LEN > sj[None, :])).astype(np.float32))
    cmp_end = jnp.arange(n_cmp) * CMP_STRIDE + CMP_LEN - 1
    tbl = rel_bias.astype(jnp.float32)
    tbl_hp = tbl.reshape(NUM_BUCKETS, G, P)
    tbl_g = tbl_hp.transpose(1, 0, 2)
    bi = jnp.arange(B)[:, None, None, None]
    gi = jnp.arange(G)[None, :, None, None]
    scale = dh ** -0.5
    blk_ids = jnp.arange(n_slc)

    def dense_bias(dist):
        return tbl_hp[t5_bucket(dist)].transpose(2, 3, 0, 1)

    def block(qb):
        t0 = qb * QB
        qpos = t0 + jnp.arange(QB)
        qblk = lax.dynamic_slice_in_dim(q, t0, QB, axis=3)
        gblk = lax.dynamic_slice_in_dim(gates, t0, QB, axis=4)
        s = (jnp.einsum('bgpqd,bgnd->bgpqn', qblk, k_cmp) * scale
             + dense_bias(qpos[:, None] - cmp_end[None, :]))
        p_c = masked_softmax(s, cmp_end[None, :] <= qpos[:, None])
        o_c = jnp.einsum('bgpqn,bgnd->bgpqd', p_c, v_cmp)
        imp = jnp.einsum('bgpqn,nj->bgqj', p_c, overlap)
        cur = qpos // SLC_LEN
        forced = ((blk_ids[None, :] == 0) | (blk_ids[None, :] == cur[:, None])
                  | (blk_ids[None, :] == cur[:, None] - 1))
        imp = jnp.where(forced, SEL_BIG, jnp.where(blk_ids[None, :] <= cur[:, None], imp, -SEL_BIG))
        _, sel = lax.top_k(imp, n_sel)
        ks = k_slc[bi, gi, sel].reshape(B, G, QB, n_sel * SLC_LEN, dh)
        vs = v_slc[bi, gi, sel].reshape(B, G, QB, n_sel * SLC_LEN, dh)
        kpos = (sel[..., None] * SLC_LEN + jnp.arange(SLC_LEN)).reshape(B, G, QB, n_sel * SLC_LEN)
        dist = qpos[None, None, :, None] - kpos
        bias_s = jnp.moveaxis(tbl_g[gi, t5_bucket(dist)], -1, 2)
        s = jnp.einsum('bgpqd,bgqkd->bgpqk', qblk, ks) * scale + bias_s
        p_s = masked_softmax(s, (dist >= 0)[:, :, None])
        o_s = jnp.einsum('bgpqk,bgqkd->bgpqd', p_s, vs)
        kw = lax.dynamic_slice_in_dim(k_win, t0, QB + WINDOW, axis=2)
        vw = lax.dynamic_slice_in_dim(v_win, t0, QB + WINDOW, axis=2)
        wpos = t0 - WINDOW + jnp.arange(QB + WINDOW)
        dist_w = qpos[:, None] - wpos[None, :]
        valid_w = (dist_w >= 0) & (dist_w < WINDOW) & (wpos[None, :] >= 0)
        s = jnp.einsum('bgpqd,bgkd->bgpqk', qblk, kw) * scale + dense_bias(dist_w)
        p_w = masked_softmax(s, valid_w)
        o_w = jnp.einsum('bgpqk,bgkd->bgpqd', p_w, vw)
        return (gblk[:, 0, ..., None] * o_c + gblk[:, 1, ..., None] * o_s
                + gblk[:, 2, ..., None] * o_w)

    o = lax.map(block, jnp.arange(T // QB))
    o = o.transpose(1, 0, 4, 2, 3, 5).reshape(B, T, H * dh)
    return o.astype(xn.dtype) @ w_out


def setup_inputs(seed: int = 0) -> dict:
    key = jax.random.key(seed)
    ks = jax.random.split(key, 20)
    f32 = jnp.float32

    def w(k, shape, fan_in):
        return jax.random.normal(k, shape, f32) * (fan_in ** -0.5)

    def gain(k, shape):
        return 1.0 + 0.02 * jax.random.normal(k, shape, f32)

    return {
        "x": jax.random.normal(ks[0], (BATCH, SEQ, D_MODEL), f32),
        "ffn1_norm": gain(ks[1], (DEPTH, D_MODEL)),
        "ffn1_w_gu": w(ks[2], (DEPTH, D_MODEL, 2 * D_FF), D_MODEL),
        "ffn1_w_down": w(ks[3], (DEPTH, D_FF, D_MODEL), D_FF),
        "mix_norm": gain(ks[4], (DEPTH, D_MODEL)),
        "ffn2_norm": gain(ks[5], (DEPTH, D_MODEL)),
        "ffn2_w_gu": w(ks[6], (DEPTH, D_MODEL, 2 * D_FF), D_MODEL),
        "ffn2_w_down": w(ks[7], (DEPTH, D_FF, D_MODEL), D_FF),
        "ret_w_in": w(ks[8], (N_RET_LAYERS, D_MODEL, RET_IN), D_MODEL),
        "ret_w_out": w(ks[9], (N_RET_LAYERS, RET_HEADS * RET_DV, D_MODEL), RET_HEADS * RET_DV),
        "nsa_w_in": w(ks[10], (N_NSA_LAYERS, D_MODEL, NSA_IN), D_MODEL),
        "nsa_w_out": w(ks[11], (N_NSA_LAYERS, NSA_HEADS * NSA_DH, D_MODEL), NSA_HEADS * NSA_DH),
        "nsa_q_gain": gain(ks[12], (N_NSA_LAYERS, NSA_DH)),
        "nsa_k_gain": gain(ks[13], (N_NSA_LAYERS, 3, NSA_DH)),
        "nsa_cmp_pos": 0.1 * jax.random.normal(ks[14], (N_NSA_LAYERS, 2, CMP_LEN, NSA_DH), f32),
        "nsa_cmp_w1": w(ks[15], (N_NSA_LAYERS, 2, CMP_LEN * NSA_DH, CMP_HID), CMP_LEN * NSA_DH),
        "nsa_cmp_w2": w(ks[16], (N_NSA_LAYERS, 2, CMP_HID, NSA_DH), CMP_HID),
        "rel_bias": 0.5 * jax.random.normal(ks[17], (NUM_BUCKETS, NSA_HEADS), f32),
    }


def reference(x, ffn1_norm, ffn1_w_gu, ffn1_w_down, mix_norm, ffn2_norm, ffn2_w_gu, ffn2_w_down,
              ret_w_in, ret_w_out, nsa_w_in, nsa_w_out, nsa_q_gain, nsa_k_gain,
              nsa_cmp_pos, nsa_cmp_w1, nsa_cmp_w2, rel_bias):
    for layer in range(DEPTH):
        x = x + 0.5 * swiglu_ffn(x, ffn1_norm[layer], ffn1_w_gu[layer], ffn1_w_down[layer])
        xn = rmsnorm(x, mix_norm[layer])
        j = layer // N_MIXERS
        if layer % N_MIXERS == 0:
            m = retention(xn, ret_w_in[j], ret_w_out[j])
        else:
            m = nsa(xn, nsa_w_in[j], nsa_w_out[j], nsa_q_gain[j], nsa_k_gain[j],
                    nsa_cmp_pos[j], nsa_cmp_w1[j], nsa_cmp_w2[j], rel_bias)
        x = x + m
        x = x + 0.5 * swiglu_ffn(x, ffn2_norm[layer], ffn2_w_gu[layer], ffn2_w_down[layer])
    return x
```

```cpp
#include <hip/hip_runtime.h>
#include <hip/hip_cooperative_groups.h>
#include <cstdio>
#include <cstdint>
namespace cg = cooperative_groups;

#ifndef MK_ONE_LAUNCH
#define MK_ONE_LAUNCH 1
#endif

#define DI __device__ __forceinline__
#define LAS __attribute__((address_space(3)))
typedef unsigned short bf16_t;
typedef short bf16x8 __attribute__((ext_vector_type(8)));
typedef short s16x4 __attribute__((ext_vector_type(4)));
typedef float f32x2 __attribute__((ext_vector_type(2)));
typedef float f32x4 __attribute__((ext_vector_type(4)));
typedef float f32x16 __attribute__((ext_vector_type(16)));
typedef unsigned u32x2 __attribute__((ext_vector_type(2)));
typedef unsigned u32x4 __attribute__((ext_vector_type(4)));
typedef __bf16 bf16x2_t __attribute__((ext_vector_type(2)));

constexpr int NB = 16, T = 2048, D = 1024, M = NB * T, DFF = 2816, NGU = 2 * DFF;
constexpr int DEPTH = 4;
constexpr float EPS = 1e-6f;
constexpr float LOG2E = 1.4426950408889634f;
constexpr int NSA_NPAD = 2816;
constexpr int NTHR = 512;

constexpr size_t MiB = 1u << 20;
constexpr size_t OFF_SSQ = 0;
constexpr size_t OFF_HSSQ = 1 * MiB;
constexpr size_t OFF_COS = 5 * MiB, OFF_SIN = 6 * MiB;
constexpr size_t OFF_CB1 = 7 * MiB;
constexpr size_t OFF_W = 8 * MiB;
constexpr size_t WGU_SZ = (size_t)NGU * D * 2, WD_SZ = (size_t)D * DFF * 2, FFN_SZ = WGU_SZ + WD_SZ;
constexpr size_t OFF_WFFN = OFF_W;
constexpr size_t RETIN_SZ = (size_t)6144 * D * 2, RETOUT_SZ = (size_t)D * 2048 * 2, RET_SZ = RETIN_SZ + RETOUT_SZ;
constexpr size_t OFF_WRET = OFF_WFFN + 8 * FFN_SZ;
constexpr size_t NSAIN_SZ = (size_t)NSA_NPAD * D * 2, NSAOUT_SZ = (size_t)D * D * 2, NSAW1_SZ = (size_t)256 * 2048 * 2, NSA_SZ = NSAIN_SZ + NSAOUT_SZ + 2 * NSAW1_SZ;
constexpr size_t OFF_WNSA = OFF_WRET + 2 * RET_SZ;
constexpr size_t OFF_WEND = OFF_WNSA + 2 * NSA_SZ;
constexpr size_t OFF_XB = 192 * MiB;
static_assert(OFF_WEND <= OFF_XB, "weights fit");
constexpr size_t OFF_LOC = 256 * MiB;
constexpr size_t OFF_ACT = OFF_LOC;
constexpr size_t OFF_RVO = OFF_LOC;
constexpr size_t OB_RQ = 0, OB_RK = 64 * MiB;
constexpr size_t OB_NO = 0, OB_PART = 64 * MiB;
constexpr size_t OFF_XLO = OFF_LOC + 192 * MiB;
constexpr size_t OFF_NQ = OFF_LOC;
constexpr size_t OFF_NKV = OFF_LOC + 64 * MiB;
constexpr size_t KVSEC = (size_t)NB * 4 * T * 64;
constexpr size_t OFF_NGATE = OFF_LOC + 160 * MiB;
constexpr size_t OFF_NKC = OFF_LOC + 166 * MiB, OFF_NVC = OFF_LOC + 167 * MiB;
constexpr size_t WS_NEED = 512 * MiB;

constexpr int LDS_BYTES = 163840;
constexpr int EPI_LDS = 131072;

DI unsigned cvtpk(float lo, float hi) { f32x2 v = {lo, hi}; bf16x2_t b = __builtin_convertvector(v, bf16x2_t); return __builtin_bit_cast(unsigned, b); }
DI float bf2f(unsigned short h) { return __uint_as_float(((unsigned)h) << 16); }
DI float bflo(unsigned u) { return __uint_as_float(u << 16); }
DI float bfhi(unsigned u) { return __uint_as_float(u & 0xffff0000u); }
DI float fexp2(float x) { return __builtin_amdgcn_exp2f(x); }
DI float frcp(float x) { return __builtin_amdgcn_rcpf(x); }
DI float sigmoidf_(float x) { return frcp(1.0f + fexp2(-x * LOG2E)); }
DI float siluf_(float x) { return x * sigmoidf_(x); }
DI float pairsum(float v) { auto rr = __builtin_amdgcn_permlane32_swap(__float_as_uint(v), __float_as_uint(v), false, false); return __uint_as_float(rr[0]) + __uint_as_float(rr[1]); }
DI float pairmax(float v) { auto rr = __builtin_amdgcn_permlane32_swap(__float_as_uint(v), __float_as_uint(v), false, false); return fmaxf(__uint_as_float(rr[0]), __uint_as_float(rr[1])); }
DI float wave_sum(float v) {
#pragma unroll
    for (int o = 1; o < 64; o <<= 1) v += __shfl_xor(v, o);
    return v;
}
DI u32x4 widen_pair(u32x2 X, u32x2 Y) {
    auto r0 = __builtin_amdgcn_permlane32_swap(X.x, Y.x, false, false); auto r1 = __builtin_amdgcn_permlane32_swap(X.y, Y.y, false, false);
    return (u32x4){r0[0], r1[0], r0[1], r1[1]};
}
DI int crow(int r, int hi) { return (r & 3) + 8 * (r >> 2) + 4 * hi; }
#define MFMA32(a, b, c) __builtin_amdgcn_mfma_f32_32x32x16_bf16((a), (b), (c), 0, 0, 0)
typedef short v4i16_t __attribute__((ext_vector_type(4)));
DI s16x4 trread(LAS const unsigned char* p) { return __builtin_bit_cast(s16x4, __builtin_amdgcn_ds_read_tr16_b64_v4i16((LAS v4i16_t*)p)); }
DI bf16x8 trfrag(LAS const unsigned char* img, int pitch, int row0, int col0, int lane) {
    const int hi = lane >> 5, q = (lane & 15) >> 2, p = lane & 3, blk = (lane >> 4) & 1;
    LAS const unsigned char* a = img + (row0 + 4 * hi + q) * pitch + (col0 + 16 * blk) * 2 + 8 * p;
    const s16x4 lo = trread(a), hh = trread(a + 8 * pitch);
    return (bf16x8){lo[0], lo[1], lo[2], lo[3], hh[0], hh[1], hh[2], hh[3]};
}
DI bf16x8 pack8(const f32x16& x, int s) {
    u32x4 p; p.x = cvtpk(x[8 * s], x[8 * s + 1]); p.y = cvtpk(x[8 * s + 2], x[8 * s + 3]); p.z = cvtpk(x[8 * s + 4], x[8 * s + 5]); p.w = cvtpk(x[8 * s + 6], x[8 * s + 7]);
    return __builtin_bit_cast(bf16x8, p);
}

namespace pg8 {
constexpr int BM = 256, BK = 64, HALF = 128, HTB = HALF * BK * 2, NXCD = 8, WGM = 8;
__host__ __device__ __forceinline__ int lds_byte(int r, int c) { const int st = (r >> 4) * 2 + (c >> 5), rr = r & 15, cc = c & 31, ob = rr * 64 + cc * 2; return st * 1024 + (ob ^ (((ob >> 9) & 1) << 5)); }
__host__ __device__ __forceinline__ void stage_rc(int b, int& R, int& C) { const int st = b / 1024, sb = b % 1024, swz = sb ^ (((sb >> 9) & 1) << 5); R = (st >> 1) * 16 + swz / 64; C = (st & 1) * 32 + (swz % 64) / 2; }
__host__ __device__ __forceinline__ int perm32(int rho) { const int n = rho >> 4, i = rho & 15; return 8 * (i >> 2) + 4 * n + (i & 3); }
struct Unit { int pm, pn; };
struct Gemm { const bf16_t* A; const bf16_t* Bt; int M, N, K, lda, ldb; };
struct StaticOrder {
    int nM, nN, nwg, G, c;
    __device__ void init(int M_, int N_, int G_, int c_) { nM = M_ / BM; nN = N_ / BM; nwg = nM * nN; G = G_; c = c_; }
    __device__ bool next(int i, Unit& u) const {
        const long L = (long)i * G + c; if (L >= nwg) return false;
        int wgid = (int)L; { const int q = nwg / NXCD, r = nwg % NXCD, xcd = wgid % NXCD, off = wgid / NXCD; wgid = (xcd < r ? xcd * (q + 1) : r * (q + 1) + (xcd - r) * q) + off; }
        const int nig = WGM * nN, gid = wgid / nig, fm = gid * WGM, gsz = (nM - fm) < WGM ? (nM - fm) : WGM;
        u.pm = fm + ((wgid % nig) % gsz); u.pn = (wgid % nig) / gsz; return true;
    }
};
template <class Epi>
__device__ __forceinline__ void gemm_phase(LAS unsigned char* lds, const Gemm g, const StaticOrder& S, const Epi& E, const int tid) {
    const int wid = __builtin_amdgcn_readfirstlane(tid >> 6), lane = tid & 63, wr = wid >> 2, wc = wid & 3, fr = lane & 15, fq = lane >> 4;
    const int K = g.K, nt = K / BK, ldb = g.ldb ? g.ldb : K;
    unsigned voffA[2], voffB[2];
#pragma unroll
    for (int i = 0; i < 2; ++i) { int R, C; stage_rc(tid * 16 + i * 8192, R, C); const int Rb = Epi::PERM ? ((R & ~31) + perm32(R & 31)) : R;
        voffA[i] = (unsigned)(R * g.lda + C) * 2u; voffB[i] = (unsigned)(Rb * ldb + C) * 2u; }
    const size_t kstep = (size_t)(BK * 2);
    const size_t hstepA = (size_t)HALF * g.lda * 2, hstepB = (size_t)HALF * ldb * 2;
    const size_t tstepA = 2 * hstepA, tstepB = 2 * hstepB;
    const unsigned ldsw = (unsigned)wid * 1024u;
    const int aoff = lds_byte(wr * 64 + fr, fq * 8), boff = lds_byte(wc * 32 + fr, fq * 8);
#define PG8_SA(b, h) (((b) * 2 + (h)) * HTB)
#define PG8_SB(b, h) ((4 + (b) * 2 + (h)) * HTB)
#define PG8_STAGE(bufoff, gbase, voff) do { _Pragma("unroll") for (int _i = 0; _i < 2; ++_i) \
        __builtin_amdgcn_global_load_lds((const unsigned*)((const char*)(gbase) + (voff)[_i]), (LAS unsigned*)(lds + (bufoff) + ldsw + _i * 8192), 16, 0, 0); } while (0)
#define PG8_LDA(dst, b, h) do { _Pragma("unroll") for (int m = 0; m < 4; ++m) _Pragma("unroll") for (int k = 0; k < 2; ++k) dst[m][k] = *(const LAS bf16x8*)(lds + PG8_SA(b, h) + aoff + m * 2048 + k * 1024); } while (0)
#define PG8_LDB(dst, b, h) do { _Pragma("unroll") for (int n = 0; n < 2; ++n) _Pragma("unroll") for (int k = 0; k < 2; ++k) dst[n][k] = *(const LAS bf16x8*)(lds + PG8_SB(b, h) + boff + n * 2048 + k * 1024); } while (0)
#define PG8_MMA(ai, bj, At, Bt) do { __builtin_amdgcn_s_setprio(1); _Pragma("unroll") for (int m = 0; m < 4; ++m) _Pragma("unroll") for (int n = 0; n < 2; ++n) _Pragma("unroll") for (int k = 0; k < 2; ++k) \
        acc[ai][bj][m][n] = __builtin_amdgcn_mfma_f32_16x16x32_bf16(Bt[n][k], At[m][k], acc[ai][bj][m][n], 0, 0, 0); __builtin_amdgcn_s_setprio(0); } while (0)
#define PG8_WAIT_V(n) asm volatile("s_waitcnt vmcnt(" #n ")" ::: "memory")
#define PG8_WAIT_L(n) asm volatile("s_waitcnt lgkmcnt(" #n ")" ::: "memory")
#define PG8_BAR __builtin_amdgcn_s_barrier()
#define PG8_SCHED __builtin_amdgcn_sched_barrier(0)
    Unit cur, nxt; int ui = 0;
    if (!S.next(0, cur)) return;
    f32x4 acc[2][2][4][2];
#pragma unroll
    for (int a = 0; a < 2; ++a)
#pragma unroll
        for (int b = 0; b < 2; ++b)
#pragma unroll
            for (int m = 0; m < 4; ++m)
#pragma unroll
                for (int n = 0; n < 2; ++n) acc[a][b][m][n] = (f32x4){0.f, 0.f, 0.f, 0.f};
    bf16x8 At[4][2], B0[2][2], B1[2][2];
    float rs[8];
    E.pre(cur, wr, fr, rs);
    const char* cA = (const char*)g.A + (size_t)cur.pm * tstepA; const char* cB = (const char*)g.Bt + (size_t)cur.pn * tstepB;
    PG8_STAGE(PG8_SB(0, 0), cB, voffB); PG8_STAGE(PG8_SB(0, 1), cB + hstepB, voffB); PG8_STAGE(PG8_SA(0, 0), cA, voffA); PG8_STAGE(PG8_SA(0, 1), cA + hstepA, voffA);
    if (wr == 1) PG8_BAR;
    PG8_WAIT_V(2); PG8_BAR;
    PG8_STAGE(PG8_SB(1, 0), cB + kstep, voffB); PG8_STAGE(PG8_SA(1, 0), cA + kstep, voffA); PG8_STAGE(PG8_SB(1, 1), cB + hstepB + kstep, voffB);
    PG8_WAIT_V(6); PG8_BAR;
    for (;;) {
        const bool has_next = S.next(ui + 1, nxt);
        const char* nA = has_next ? (const char*)g.A + (size_t)nxt.pm * tstepA : cA; const char* nB = has_next ? (const char*)g.Bt + (size_t)nxt.pn * tstepB : cB;
        for (int t = 0; t < nt; t += 2) {
            const bool last = (t == nt - 2);
            const char* a1 = cA + (size_t)(t + 1) * kstep;
            const char* a2 = last ? nA : cA + (size_t)(t + 2) * kstep; const char* b2 = last ? nB : cB + (size_t)(t + 2) * kstep;
            const char* a3 = a2 + kstep; const char* b3 = b2 + kstep;
            PG8_LDB(B0, 0, 0); PG8_LDB(B1, 0, 1); PG8_SCHED; PG8_LDA(At, 0, 0); PG8_STAGE(PG8_SA(1, 1), a1 + hstepA, voffA);
            PG8_WAIT_V(8); PG8_WAIT_L(0); PG8_BAR; PG8_MMA(0, 0, At, B0); PG8_MMA(0, 1, At, B1); PG8_BAR; PG8_SCHED;
            PG8_LDA(At, 0, 1); PG8_STAGE(PG8_SB(0, 0), b2, voffB); PG8_STAGE(PG8_SB(0, 1), b2 + hstepB, voffB); PG8_STAGE(PG8_SA(0, 0), a2, voffA);
            PG8_WAIT_V(8); PG8_WAIT_L(0); PG8_BAR; PG8_MMA(1, 0, At, B0); PG8_MMA(1, 1, At, B1); PG8_BAR; PG8_SCHED;
            PG8_LDB(B0, 1, 0); PG8_LDB(B1, 1, 1); PG8_SCHED; PG8_LDA(At, 1, 0); PG8_STAGE(PG8_SA(0, 1), a2 + hstepA, voffA);
            PG8_WAIT_V(8); PG8_WAIT_L(0); PG8_BAR; PG8_MMA(0, 0, At, B0); PG8_MMA(0, 1, At, B1); PG8_BAR; PG8_SCHED;
            PG8_LDA(At, 1, 1); PG8_STAGE(PG8_SB(1, 0), b3, voffB); PG8_STAGE(PG8_SB(1, 1), b3 + hstepB, voffB); PG8_STAGE(PG8_SA(1, 0), a3, voffA);
            PG8_WAIT_V(8); PG8_WAIT_L(0); PG8_BAR; PG8_MMA(1, 0, At, B0); PG8_MMA(1, 1, At, B1); PG8_BAR; PG8_SCHED;
        }
        if (wr == 0) PG8_BAR;
        E(acc, cur, wr, wc, fr, fq, wid, lane, rs);
        if (!has_next) break;
        E.pre(nxt, wr, fr, rs);
#pragma unroll
        for (int a = 0; a < 2; ++a)
#pragma unroll
            for (int b = 0; b < 2; ++b)
#pragma unroll
                for (int m = 0; m < 4; ++m)
#pragma unroll
                    for (int n = 0; n < 2; ++n) acc[a][b][m][n] = (f32x4){0.f, 0.f, 0.f, 0.f};
        cur = nxt; cA = nA; cB = nB; ++ui;
        if (wr == 1) PG8_BAR;
    }
    PG8_WAIT_V(0);
    PG8_BAR;
#undef PG8_SA
#undef PG8_SB
#undef PG8_STAGE
#undef PG8_LDA
#undef PG8_LDB
#undef PG8_MMA
#undef PG8_WAIT_V
#undef PG8_WAIT_L
#undef PG8_BAR
#undef PG8_SCHED
}
}
using pg8::Unit;
typedef const f32x4 (&AccRef)[2][2][4][2];

DI float row_rstd(const float* ssq, int r) { const f32x4 p = *(const f32x4*)(ssq + (size_t)r * 4); return __builtin_amdgcn_rsqf((p.x + p.y + p.z + p.w) * (1.0f / D) + EPS); }
DI u32x4 pack8f(const f32x4& a, const f32x4& b) { u32x4 w; w.x = cvtpk(a[0], a[1]); w.y = cvtpk(a[2], a[3]); w.z = cvtpk(b[0], b[1]); w.w = cvtpk(b[2], b[3]); return w; }

struct EpiSwiglu {
    static constexpr bool PERM = true;
    const float* ssq; bf16_t* act;
    DI void pre(const Unit& u, int wr, int fr, float (&rs)[8]) const {
#pragma unroll
        for (int ai = 0; ai < 2; ++ai)
#pragma unroll
            for (int m = 0; m < 4; ++m) rs[ai * 4 + m] = row_rstd(ssq, u.pm * 256 + ai * 128 + wr * 64 + m * 16 + fr);
    }
    DI void operator()(AccRef acc, const Unit& u, int wr, int wc, int fr, int fq, int, int, const float (&rsv)[8]) const {
#pragma unroll
        for (int ai = 0; ai < 2; ++ai)
#pragma unroll
            for (int m = 0; m < 4; ++m) {
                const int r = u.pm * 256 + ai * 128 + wr * 64 + m * 16 + fr; const float rs = rsv[ai * 4 + m];
                f32x4 v[2];
#pragma unroll
                for (int n = 0; n < 2; ++n) { const f32x4 a = acc[ai][0][m][n] * rs, b = acc[ai][1][m][n] * rs;
#pragma unroll
                    for (int j = 0; j < 4; ++j) v[n][j] = siluf_(a[j]) * b[j]; }
                *(u32x4*)(act + (size_t)r * DFF + u.pn * 128 + wc * 32 + 8 * fq) = pack8f(v[0], v[1]);
            }
    }
};
DI float fp8f(unsigned w, int i) { return i == 0 ? __builtin_amdgcn_cvt_f32_fp8((int)w, 0) : i == 1 ? __builtin_amdgcn_cvt_f32_fp8((int)w, 1) : i == 2 ? __builtin_amdgcn_cvt_f32_fp8((int)w, 2) : __builtin_amdgcn_cvt_f32_fp8((int)w, 3); }
DI float clamp8(float v) { return __builtin_fminf(__builtin_fmaxf(v, -448.f), 448.f); }
DI unsigned pk4fp8(float a, float b, float c, float d) { int p = 0; a = clamp8(a); b = clamp8(b); c = clamp8(c); d = clamp8(d); p = __builtin_amdgcn_cvt_pk_fp8_f32(a, b, p, false); p = __builtin_amdgcn_cvt_pk_fp8_f32(c, d, p, true); return (unsigned)p; }
struct EpiResid {
    static constexpr bool PERM = true;
    const float* x32in; float* x32out; bf16_t* xb; unsigned char* xlo; float* ssq; float alpha; LAS float* P;
    DI void pre(const Unit&, int, int, float (&)[8]) const {}
    static constexpr int RDEPTH = 4;
    DI void operator()(AccRef acc, const Unit& u, int wr, int wc, int fr, int fq, int wid, int lane, const float (&rsv)[8]) const {
        const int c0 = u.pn * 256 + wc * 32 + 8 * fq;
        const size_t base = (size_t)(u.pm * 256 + wr * 64 + fr) * D + c0;
        const bool first = x32in != nullptr, last = x32out != nullptr;
        u32x4 L[RDEPTH][4];
#define RES_OFF(p) (base + (size_t)(((p) >> 2) * 128 + ((p) & 3) * 16) * D)
#define RES_LOAD(p) do { const size_t o_ = RES_OFF(p); \
            if (first) { const float* q_ = x32in + o_; L[(p) % RDEPTH][0] = *(const u32x4*)(q_); L[(p) % RDEPTH][1] = *(const u32x4*)(q_ + 4); L[(p) % RDEPTH][2] = *(const u32x4*)(q_ + 128); L[(p) % RDEPTH][3] = *(const u32x4*)(q_ + 132); } \
            else { L[(p) % RDEPTH][0] = *(const u32x4*)(xb + o_); { const u32x2 t_ = *(const u32x2*)(xlo + o_); L[(p) % RDEPTH][1].x = t_.x; L[(p) % RDEPTH][1].y = t_.y; } \
                   L[(p) % RDEPTH][2] = *(const u32x4*)(xb + o_ + 128); { const u32x2 t_ = *(const u32x2*)(xlo + o_ + 128); L[(p) % RDEPTH][3].x = t_.x; L[(p) % RDEPTH][3].y = t_.y; } } } while (0)
#pragma unroll
        for (int p = 0; p < RDEPTH; ++p) RES_LOAD(p);
#pragma unroll
        for (int p = 0; p < 8; ++p) {
            const int ai = p >> 2, m = p & 3; const int rl = ai * 128 + wr * 64 + m * 16 + fr; const size_t off = RES_OFF(p); float ss = 0.f;
#pragma unroll
            for (int bj = 0; bj < 2; ++bj) { const size_t o = off + bj * 128;
                const u32x4 A0 = L[p % RDEPTH][2 * bj], A1 = L[p % RDEPTH][2 * bj + 1];
                f32x4 v0, v1; constexpr float IS = 1.0f / 512.0f;
                if (first) { v0 = __builtin_bit_cast(f32x4, A0); v1 = __builtin_bit_cast(f32x4, A1); }
                else { v0 = (f32x4){bflo(A0.x) + fp8f(A1.x, 0) * IS, bfhi(A0.x) + fp8f(A1.x, 1) * IS, bflo(A0.y) + fp8f(A1.x, 2) * IS, bfhi(A0.y) + fp8f(A1.x, 3) * IS};
                       v1 = (f32x4){bflo(A0.z) + fp8f(A1.y, 0) * IS, bfhi(A0.z) + fp8f(A1.y, 1) * IS, bflo(A0.w) + fp8f(A1.y, 2) * IS, bfhi(A0.w) + fp8f(A1.y, 3) * IS}; }
                v0 = v0 + acc[ai][bj][m][0] * alpha; v1 = v1 + acc[ai][bj][m][1] * alpha;
                if (last) { *(f32x4*)(x32out + o) = v0; *(f32x4*)(x32out + o + 4) = v1; }
                else { const u32x4 hw = pack8f(v0, v1); u32x2 lw;
                    lw.x = pk4fp8((v0[0] - bflo(hw.x)) * 512.f, (v0[1] - bfhi(hw.x)) * 512.f, (v0[2] - bflo(hw.y)) * 512.f, (v0[3] - bfhi(hw.y)) * 512.f);
                    lw.y = pk4fp8((v1[0] - bflo(hw.z)) * 512.f, (v1[1] - bfhi(hw.z)) * 512.f, (v1[2] - bflo(hw.w)) * 512.f, (v1[3] - bfhi(hw.w)) * 512.f);
                    *(u32x4*)(xb + o) = hw; *(u32x2*)(xlo + o) = lw; }
                ss += (v0[0] * v0[0] + v0[1] * v0[1]) + (v0[2] * v0[2] + v0[3] * v0[3]) + (v1[0] * v1[0] + v1[1] * v1[1]) + (v1[2] * v1[2] + v1[3] * v1[3]); }
            if (p + RDEPTH < 8) RES_LOAD(p + RDEPTH);
            ss += __shfl_xor(ss, 16); ss += __shfl_xor(ss, 32);
            if (fq == 0) P[rl * 4 + wc] = ss;
        }
#undef RES_LOAD
#undef RES_OFF
        asm volatile("s_waitcnt lgkmcnt(0)" ::: "memory"); __builtin_amdgcn_s_barrier(); asm volatile("" ::: "memory");
        if (lane < 32) { const int row = wid * 32 + lane; const f32x4 p = *(const LAS f32x4*)(P + row * 4); ssq[(size_t)(u.pm * 256 + row) * 4 + u.pn] = (p.x + p.y) + (p.z + p.w); }
    }
};
struct EpiRetQKV {
    static constexpr bool PERM = true;
    const float* ssq; const float* cs; const float* sn; bf16_t* Q; bf16_t* K; bf16_t* VO;
    DI void pre(const Unit& u, int wr, int fr, float (&rs)[8]) const {
#pragma unroll
        for (int ai = 0; ai < 2; ++ai)
#pragma unroll
            for (int m = 0; m < 4; ++m) rs[ai * 4 + m] = row_rstd(ssq, u.pm * 256 + ai * 128 + wr * 64 + m * 16 + fr);
    }
    DI void operator()(AccRef acc, const Unit& u, int wr, int wc, int fr, int fq, int, int, const float (&rsv)[8]) const {
        const int pn = u.pn;
        if (pn < 8) {
            constexpr int QDEPTH = 3;
            const int hd = pn & 3, i0 = wc * 32 + 8 * fq; const int r0 = u.pm * 256 + wr * 64 + fr;
            f32x4 CS[QDEPTH][4];
#define QKV_ROW(p) (r0 + ((p) >> 2) * 128 + ((p) & 3) * 16)
#define QKV_LOAD(p) do { const int t_ = QKV_ROW(p) & 2047; const float* c_ = cs + t_ * 128 + i0; const float* s_ = sn + t_ * 128 + i0; \
                CS[(p) % QDEPTH][0] = *(const f32x4*)c_; CS[(p) % QDEPTH][1] = *(const f32x4*)(c_ + 4); CS[(p) % QDEPTH][2] = *(const f32x4*)s_; CS[(p) % QDEPTH][3] = *(const f32x4*)(s_ + 4); } while (0)
#pragma unroll
            for (int p = 0; p < QDEPTH; ++p) QKV_LOAD(p);
#pragma unroll
            for (int p = 0; p < 8; ++p) { const int ai = p >> 2, m = p & 3; const int r = QKV_ROW(p); const float rs = rsv[p];
                const int b = r >> 11, t = r & 2047; const float sc = pn >= 4 ? rs * 0.0625f : rs;
                bf16_t* dst = (pn >= 4 ? K : Q) + ((size_t)(b * 4 + hd) * T + t) * 256 + i0;
                f32x4 o1[2], o2[2];
#pragma unroll
                for (int n = 0; n < 2; ++n) { const f32x4 c = CS[p % QDEPTH][n], sv = CS[p % QDEPTH][2 + n];
                    const f32x4 x1 = acc[ai][0][m][n] * sc, x2 = acc[ai][1][m][n] * sc; o1[n] = x1 * c - x2 * sv; o2[n] = x1 * sv + x2 * c; }
                *(u32x4*)dst = pack8f(o1[0], o1[1]); *(u32x4*)(dst + 128) = pack8f(o2[0], o2[1]);
                if (p + QDEPTH < 8) QKV_LOAD(p + QDEPTH); }
#undef QKV_LOAD
#undef QKV_ROW
        } else {
#pragma unroll
            for (int ai = 0; ai < 2; ++ai)
#pragma unroll
                for (int m = 0; m < 4; ++m) {
                    const int r = u.pm * 256 + ai * 128 + wr * 64 + m * 16 + fr; const float rs = rsv[ai * 4 + m];
                    bf16_t* dst = VO + (size_t)r * 2048 + (pn - 8) * 256 + wc * 32 + 8 * fq;
#pragma unroll
                    for (int bj = 0; bj < 2; ++bj) *(u32x4*)(dst + bj * 128) = pack8f(acc[ai][bj][m][0] * rs, acc[ai][bj][m][1] * rs);
                }
        }
    }
};

struct EpiRetG {
    static constexpr bool PERM = true;
    const float* ssq; const float* hssq; bf16_t* VO;
    DI void pre(const Unit& u, int wr, int fr, float (&rs)[8]) const {
#pragma unroll
        for (int ai = 0; ai < 2; ++ai)
#pragma unroll
            for (int m = 0; m < 4; ++m) rs[ai * 4 + m] = row_rstd(ssq, u.pm * 256 + ai * 128 + wr * 64 + m * 16 + fr);
    }
    DI void operator()(AccRef acc, const Unit& u, int wr, int wc, int fr, int fq, int, int, const float (&rsv)[8]) const {
        const int hd = u.pn >> 1;
        constexpr int GDEPTH = 4;
        const int r0 = u.pm * 256 + wr * 64 + fr; const int cc = u.pn * 256 + wc * 32 + 8 * fq;
        u32x4 L[GDEPTH][4];
#define G_ROW(p) (r0 + ((p) >> 2) * 128 + ((p) & 3) * 16)
#define G_LOAD(p) do { const int r_ = G_ROW(p); const bf16_t* d_ = VO + (size_t)r_ * 2048 + cc; const float* h_ = hssq + ((size_t)r_ * 4 + hd) * 8; \
            L[(p) % GDEPTH][0] = *(const u32x4*)d_; L[(p) % GDEPTH][1] = *(const u32x4*)(d_ + 128); L[(p) % GDEPTH][2] = *(const u32x4*)h_; L[(p) % GDEPTH][3] = *(const u32x4*)(h_ + 4); } while (0)
#pragma unroll
        for (int p = 0; p < GDEPTH; ++p) G_LOAD(p);
#pragma unroll
        for (int p = 0; p < 8; ++p) { const int ai = p >> 2, m = p & 3; const int r = G_ROW(p); const float rs = rsv[p];
            const f32x4 h0 = __builtin_bit_cast(f32x4, L[p % GDEPTH][2]), h1 = __builtin_bit_cast(f32x4, L[p % GDEPTH][3]);
            const float rh = __builtin_amdgcn_rsqf(((h0.x + h0.y) + (h0.z + h0.w) + (h1.x + h1.y) + (h1.z + h1.w)) * (1.0f / 512.f) + EPS);
            bf16_t* dst = VO + (size_t)r * 2048 + cc;
#pragma unroll
            for (int bj = 0; bj < 2; ++bj) { const u32x4 ov = L[p % GDEPTH][bj]; f32x4 a = acc[ai][bj][m][0] * rs, b = acc[ai][bj][m][1] * rs;
                a[0] = siluf_(a[0]) * bflo(ov.x) * rh; a[1] = siluf_(a[1]) * bfhi(ov.x) * rh; a[2] = siluf_(a[2]) * bflo(ov.y) * rh; a[3] = siluf_(a[3]) * bfhi(ov.y) * rh;
                b[0] = siluf_(b[0]) * bflo(ov.z) * rh; b[1] = siluf_(b[1]) * bfhi(ov.z) * rh; b[2] = siluf_(b[2]) * bflo(ov.w) * rh; b[3] = siluf_(b[3]) * bfhi(ov.w) * rh;
                *(u32x4*)(dst + bj * 128) = pack8f(a, b); }
            if (p + GDEPTH < 8) G_LOAD(p + GDEPTH); }
#undef G_LOAD
#undef G_ROW
    }
};

struct EpiNsaIn {
    static constexpr bool PERM = true;
    const float* ssq; const float* qgain; const float* kgain; bf16_t* QN; bf16_t* KV; float* GATE;
    DI void pre(const Unit& u, int wr, int fr, float (&rs)[8]) const {
#pragma unroll
        for (int ai = 0; ai < 2; ++ai)
#pragma unroll
            for (int m = 0; m < 4; ++m) rs[ai * 4 + m] = row_rstd(ssq, u.pm * 256 + ai * 128 + wr * 64 + m * 16 + fr);
    }
    DI void operator()(AccRef acc, const Unit& u, int wr, int wc, int fr, int fq, int, int, const float (&rsv)[8]) const {
        const int pn = u.pn;
        f32x4 gv[2][2];
        { const int sec0 = pn - 4; const float* gn0 = pn < 4 ? qgain : kgain + (sec0 == 2 ? 64 : 128);
#pragma unroll
          for (int bj = 0; bj < 2; ++bj)
#pragma unroll
              for (int n = 0; n < 2; ++n) gv[bj][n] = *(const f32x4*)(gn0 + bj * 32 + 8 * fq + 4 * n); }
#pragma unroll
        for (int ai = 0; ai < 2; ++ai)
#pragma unroll
            for (int m = 0; m < 4; ++m) {
                const int r = u.pm * 256 + ai * 128 + wr * 64 + m * 16 + fr; const float rs = rsv[ai * 4 + m];
                const int b = r >> 11, t = r & 2047;
                f32x4 v[2][2];
#pragma unroll
                for (int bj = 0; bj < 2; ++bj)
#pragma unroll
                    for (int n = 0; n < 2; ++n) v[bj][n] = acc[ai][bj][m][n] * rs;
                if (pn == 10) {
                    if (wc < 2) {
#pragma unroll
                        for (int n = 0; n < 2; ++n) { const int c = wc * 32 + 8 * fq + 4 * n; if (c < 48) { f32x4 o; for (int j = 0; j < 4; ++j) o[j] = sigmoidf_(v[0][n][j]); *(f32x4*)(GATE + (size_t)r * 48 + c) = o; } }
                    }
                } else {
                    const int sec = pn - 4;
                    const bool norm = (pn < 4) || sec == 2 || sec == 4;
                    const float* gn = pn < 4 ? qgain : kgain + (sec == 2 ? 64 : 128);
                    if (norm) {
                        float ss = 0.f;
#pragma unroll
                        for (int bj = 0; bj < 2; ++bj)
#pragma unroll
                            for (int n = 0; n < 2; ++n) ss += (v[bj][n][0] * v[bj][n][0] + v[bj][n][1] * v[bj][n][1]) + (v[bj][n][2] * v[bj][n][2] + v[bj][n][3] * v[bj][n][3]);
                        ss += __shfl_xor(ss, 16); ss += __shfl_xor(ss, 32);
                        float hn = __builtin_amdgcn_rsqf(ss * (1.0f / 64.f) + EPS); if (pn < 4) hn *= 0.125f * LOG2E;
#pragma unroll
                        for (int bj = 0; bj < 2; ++bj)
#pragma unroll
                            for (int n = 0; n < 2; ++n) v[bj][n] = v[bj][n] * hn * gv[bj][n];
                    }
                    bf16_t* dst = pn < 4 ? QN + ((size_t)(b * 16 + pn * 4 + wc) * T + t) * 64 : KV + (size_t)sec * KVSEC + ((size_t)(b * 4 + wc) * T + t) * 64;
#pragma unroll
                    for (int bj = 0; bj < 2; ++bj) *(u32x4*)(dst + bj * 32 + 8 * fq) = pack8f(v[bj][0], v[bj][1]);
                }
            }
    }
};
DI float gelu_tanh(float xx) { const float uu = 0.7978845608028654f * (xx + 0.044715f * xx * xx * xx); return xx * frcp(1.0f + fexp2(-2.0f * LOG2E * uu)); }
struct EpiCmp1 {
    static constexpr bool PERM = true;
    float* part;
    DI void pre(const Unit&, int, int, float (&)[8]) const {}
    DI void operator()(AccRef acc, const Unit& u, int wr, int wc, int fr, int fq, int, int, const float (&rsv)[8]) const {
#pragma unroll
        for (int ai = 0; ai < 2; ++ai)
#pragma unroll
            for (int m = 0; m < 4; ++m) {
                const int r = u.pm * 256 + ai * 128 + wr * 64 + m * 16 + fr;
#pragma unroll
                for (int bj = 0; bj < 2; ++bj) { float* d = part + (size_t)r * 256 + bj * 128 + wc * 32 + 8 * fq; *(f32x4*)d = acc[ai][bj][m][0]; *(f32x4*)(d + 4) = acc[ai][bj][m][1]; }
            }
    }
};

struct Params {
    const float* in[18]; float* out; unsigned char* ws; int ph_lo, ph_hi;
};
enum { I_X = 0, I_F1N, I_F1GU, I_F1D, I_MIXN, I_F2N, I_F2GU, I_F2D, I_RIN, I_ROUT, I_NIN, I_NOUT, I_QG, I_KG, I_CPOS, I_CW1, I_CW2, I_RELB };
#define GAS __attribute__((address_space(1)))
DI const float* pin(const Params& P, int k) { asm volatile("" : "+s"(k)); return (const float*)(GAS const float*)P.in[k]; }

DI int map_col(int mode, int n) {
    if (mode == 0) return n;
    if (mode == 1) { const int pn = n >> 8, bj = (n >> 7) & 1, c = n & 127; return bj * DFF + pn * 128 + c; }
    const int pn = n >> 8;
    if (pn < 10) { const int wc = (n >> 5) & 3, bj = (n >> 7) & 1, i = n & 31; return pn * 256 + wc * 64 + bj * 32 + i; }
    const int cc = n - 2560; return cc < 48 ? 2560 + cc : -1;
}
DI void transpose_item(const float* W, int K, int Nsrc, bf16_t* WT, int Ndst, int mode, const float* gain, LAS float* scr, int item, int lane) {
    const int nblk = Ndst / 64, kb = item / nblk, nb = item % nblk, k0 = 64 * kb, n0 = 64 * nb;
    const int col4 = (lane & 15) * 4, sc = map_col(mode, n0 + col4);
    f32x4 v[16];
#pragma unroll
    for (int i = 0; i < 16; ++i) { const int kk = 4 * i + (lane >> 4); v[i] = sc >= 0 ? *(const f32x4*)(W + (size_t)(k0 + kk) * Nsrc + sc) : (f32x4){0.f, 0.f, 0.f, 0.f}; }
#pragma unroll
    for (int i = 0; i < 16; ++i) { const int kk = 4 * i + (lane >> 4); const float gk = gain ? gain[k0 + kk] : 1.0f; LAS float* d = scr + kk * 65 + col4;
        d[0] = v[i][0] * gk; d[1] = v[i][1] * gk; d[2] = v[i][2] * gk; d[3] = v[i][3] * gk; }
    asm volatile("s_waitcnt lgkmcnt(0)" ::: "memory");
    const int c = lane & 7;
#pragma unroll
    for (int j = 0; j < 8; ++j) { const int n = (lane >> 3) + 8 * j; const LAS float* sp = scr + (8 * c) * 65 + n;
        u32x4 o; o.x = cvtpk(sp[0 * 65], sp[1 * 65]); o.y = cvtpk(sp[2 * 65], sp[3 * 65]); o.z = cvtpk(sp[4 * 65], sp[5 * 65]); o.w = cvtpk(sp[6 * 65], sp[7 * 65]);
        *(u32x4*)(WT + (size_t)(n0 + n) * K + k0 + 8 * c) = o; }
    asm volatile("s_waitcnt lgkmcnt(0)" ::: "memory");
}
DI void prologue(const Params& P, LAS unsigned char* lds, int tid, unsigned char* ws, int bid, int G) {
    const int lane = tid & 63, wid = tid >> 6; const int gw = bid * 8 + wid, NGW = G * 8;
    LAS float* scr = (LAS float*)(lds + wid * 16640);
    for (int jid = 0; jid < 28; ++jid) {
        const float* W; int K, Nsrc, Ndst, mode; bf16_t* WT; const float* gain = nullptr;
        if (jid < 16) { const int l = jid >> 2, sub = jid & 3, which = sub >> 1; unsigned char* base = ws + OFF_WFFN + (size_t)(l * 2 + which) * FFN_SZ;
            if ((sub & 1) == 0) { W = pin(P, which ? I_F2GU : I_F1GU) + (size_t)l * D * NGU; K = D; Nsrc = NGU; Ndst = NGU; mode = 1; WT = (bf16_t*)base; gain = pin(P, which ? I_F2N : I_F1N) + l * D; }
            else { W = pin(P, which ? I_F2D : I_F1D) + (size_t)l * DFF * D; K = DFF; Nsrc = D; Ndst = D; mode = 0; WT = (bf16_t*)(base + WGU_SZ); } }
        else if (jid < 20) { const int j = (jid - 16) >> 1, sub = (jid - 16) & 1; unsigned char* base = ws + OFF_WRET + (size_t)j * RET_SZ;
            if (sub == 0) { W = pin(P, I_RIN) + (size_t)j * D * 6144; K = D; Nsrc = 6144; Ndst = 6144; mode = 0; WT = (bf16_t*)base; gain = pin(P, I_MIXN) + (2 * j) * D; }
            else { W = pin(P, I_ROUT) + (size_t)j * 2048 * D; K = 2048; Nsrc = D; Ndst = D; mode = 0; WT = (bf16_t*)(base + RETIN_SZ); } }
        else { const int j = (jid - 20) >> 2, sub = (jid - 20) & 3; unsigned char* base = ws + OFF_WNSA + (size_t)j * NSA_SZ;
            if (sub == 0) { W = pin(P, I_NIN) + (size_t)j * D * 2608; K = D; Nsrc = 2608; Ndst = NSA_NPAD; mode = 2; WT = (bf16_t*)base; gain = pin(P, I_MIXN) + (2 * j + 1) * D; }
            else if (sub == 1) { W = pin(P, I_NOUT) + (size_t)j * D * D; K = D; Nsrc = D; Ndst = D; mode = 0; WT = (bf16_t*)(base + NSAIN_SZ); }
            else { const int jj = sub - 2; W = pin(P, I_CW1) + (size_t)(j * 2 + jj) * 2048 * 256; K = 2048; Nsrc = 256; Ndst = 256; mode = 0; WT = (bf16_t*)(base + NSAIN_SZ + NSAOUT_SZ + (size_t)jj * NSAW1_SZ); } }
        const int nitems = (K / 64) * (Ndst / 64);
        for (int it = gw; it < nitems; it += NGW) transpose_item(W, K, Nsrc, WT, Ndst, mode, gain, scr, it, lane);
    }
    { const float* x = pin(P, I_X); bf16_t* xb = (bf16_t*)(ws + OFF_XB); float* ssq = (float*)(ws + OFF_SSQ);
      for (int r = gw; r < M; r += NGW) { const f32x4* xr = (const f32x4*)(x + (size_t)r * D) + lane; u32x2* brow = (u32x2*)(xb + (size_t)r * D) + lane; float s = 0.f;
#pragma unroll
          for (int j = 0; j < 4; ++j) { const f32x4 v = xr[64 * j]; u32x2 w; w.x = cvtpk(v[0], v[1]); w.y = cvtpk(v[2], v[3]); brow[64 * j] = w; s += (v[0] * v[0] + v[1] * v[1]) + (v[2] * v[2] + v[3] * v[3]); }
          s = wave_sum(s); if (lane == 0) *(f32x4*)(ssq + (size_t)r * 4) = (f32x4){s, 0.f, 0.f, 0.f}; } }
    { float* cs = (float*)(ws + OFF_COS); float* sn = (float*)(ws + OFF_SIN);
      for (int idx = bid * NTHR + tid; idx < T * 128; idx += G * NTHR) { const int t = idx >> 7, i = idx & 127;
          const float invf = exp2f(-(float)i * (13.287712379549449f / 128.f));
          const double rev = (double)t * (double)invf * 0.15915494309189535; const double fr = rev - rint(rev); const float f = (float)fr;
          cs[idx] = __builtin_amdgcn_cosf(f); sn[idx] = __builtin_amdgcn_sinf(f); } }
    if (bid < 16) { const int lj = bid >> 2, n = (bid & 3) * 64 + lane; const float* pos = pin(P, I_CPOS) + (size_t)lj * 2048; const float* w1 = pin(P, I_CW1) + (size_t)lj * 2048 * 256;
        float s = 0.f;
#pragma unroll 8
        for (int k = wid * 256; k < wid * 256 + 256; ++k) s += pos[k] * w1[(size_t)k * 256 + n];
        __syncthreads();
        LAS float* red = (LAS float*)lds; red[wid * 64 + lane] = s; __syncthreads();
        if (wid == 0) { float a = 0.f; for (int w = 0; w < 8; ++w) a += red[w * 64 + lane]; ((float*)(ws + OFF_CB1))[lj * 256 + n] = a; }
        __syncthreads(); }
}

constexpr int R_KP = 528, R_VP = 144;
constexpr int R_KI = 0, R_VI = 128 * R_KP, R_VI2 = R_VI + 128 * R_VP, R_SI = R_VI2 + 128 * R_VP, R_HX = R_SI + 64 * R_KP, R_PX = R_HX + 1024, R_END = R_PX + 10 * 2048;
static_assert(R_END <= LDS_BYTES, "retention LDS");
template <int IBT, int VBT, bool DRY> DI void ret_unit(LAS unsigned char* lds, const bf16_t* Q, const bf16_t* K, bf16_t* VO, float* hssq, int b, int h, int vs, int tid) {
    const int lane = tid & 63, wid = __builtin_amdgcn_readfirstlane(tid >> 6), r32 = lane & 31, hi = lane >> 5;
    constexpr int ib = IBT, vb = VBT; const int db = wid;
    const float lg2 = log2f(1.0f - exp2f(-5.0f - (float)h));
    const float cdec = exp2f(128.f * lg2);
    const bf16_t* Qh = Q + (size_t)(b * 4 + h) * T * 256; const bf16_t* Kh = K + (size_t)(b * 4 + h) * T * 256;
    bf16_t* Vh = VO + (size_t)b * T * 2048 + h * 512 + vs * 64;
    LAS float* HX = (LAS float*)(lds + R_HX);
    f32x16 sacc[2];
#pragma unroll
    for (int i = 0; i < 16; ++i) { sacc[0][i] = 0.f; sacc[1][i] = 0.f; }
    bf16x8 qf[16];
#pragma unroll 1
    for (int c = 0; c < 16; ++c) {
        int t2 = tid; asm volatile("" : "+v"(t2));
        const int lane = t2 & 63, r32 = lane & 31, hi = lane >> 5, iq = IBT * 32 + r32;
        u32x4 kreg[8], vreg[2];
#pragma unroll
        for (int i = 0; i < 8; ++i) { const int p = t2 + 512 * i, row = p >> 5, c16 = p & 31; kreg[i] = *(const u32x4*)(Kh + (size_t)(c * 128 + row) * 256 + c16 * 8); }
#pragma unroll
        for (int i = 0; i < 2; ++i) { const int p = t2 + 512 * i, row = p >> 3, c16 = p & 7; vreg[i] = *(const u32x4*)(Vh + (size_t)(c * 128 + row) * 2048 + c16 * 8); }
        __syncthreads();
        if (!DRY && c > 0 && tid < 128) hssq[((size_t)(b * T + (c - 1) * 128 + tid) * 4 + h) * 8 + vs] = HX[tid * 2] + HX[tid * 2 + 1];
#pragma unroll
        for (int i = 0; i < 8; ++i) { const int p = tid + 512 * i, row = p >> 5, c16 = p & 31; *(LAS u32x4*)(lds + R_KI + row * R_KP + c16 * 16) = kreg[i]; }
#pragma unroll
        for (int i = 0; i < 2; ++i) { const int p = tid + 512 * i, row = p >> 3, c16 = p & 7; *(LAS u32x4*)(lds + R_VI + row * R_VP + c16 * 16) = vreg[i];
            const float kd = exp2f((float)(127 - row) * lg2); u32x4 w;
            w.x = cvtpk(bflo(vreg[i].x) * kd, bfhi(vreg[i].x) * kd); w.y = cvtpk(bflo(vreg[i].y) * kd, bfhi(vreg[i].y) * kd);
            w.z = cvtpk(bflo(vreg[i].z) * kd, bfhi(vreg[i].z) * kd); w.w = cvtpk(bflo(vreg[i].w) * kd, bfhi(vreg[i].w) * kd);
            *(LAS u32x4*)(lds + R_VI2 + row * R_VP + c16 * 16) = w; }
#pragma unroll
        for (int vbb = 0; vbb < 2; ++vbb)
#pragma unroll
            for (int rg = 0; rg < 4; ++rg) { u32x2 w; w.x = cvtpk(sacc[vbb][4 * rg], sacc[vbb][4 * rg + 1]); w.y = cvtpk(sacc[vbb][4 * rg + 2], sacc[vbb][4 * rg + 3]);
                *(LAS u32x2*)(lds + R_SI + (vbb * 32 + r32) * R_KP + (db * 32 + 8 * rg + 4 * hi) * 2) = w; }
        __syncthreads();
        f32x16 o;
#pragma unroll
        for (int i = 0; i < 16; ++i) o[i] = 0.f;
        const int iq2 = iq, hi2 = hi;
        const bf16_t* qp = Qh + (size_t)(c * 128 + iq2) * 256 + 8 * hi2;
        if (c == 0) {
#pragma unroll
            for (int s = 0; s < 16; ++s) qf[s] = *(const bf16x8*)(qp + 16 * s);
        }
        {
            constexpr int j0 = VBT ? 2 : 0;
            constexpr int nj = VBT ? (IBT >= 2 ? IBT - 1 : 0) : (IBT >= 1 ? 2 : 1);
            f32x16 a[2];
#pragma unroll
            for (int jj = 0; jj < 2; ++jj)
#pragma unroll
                for (int i = 0; i < 16; ++i) a[jj][i] = 0.f;
            bf16x8 F[2][3];
#define RET_LOADSTEP(FF, sx) do { const int so = (16 * (sx) + 8 * hi) * 2; \
                FF[0] = *(const LAS bf16x8*)(lds + R_SI + (vb * 32 + r32) * R_KP + so); \
                _Pragma("unroll") for (int jj = 0; jj < 2; ++jj) if (jj < nj) FF[1 + jj] = *(const LAS bf16x8*)(lds + R_KI + ((j0 + jj) * 32 + r32) * R_KP + so); } while (0)
#define RET_MMASTEP(FF, sx) do { o = MFMA32(FF[0], qf[sx], o); \
                _Pragma("unroll") for (int jj = 0; jj < 2; ++jj) if (jj < nj) a[jj] = MFMA32(FF[1 + jj], qf[sx], a[jj]); } while (0)
            RET_LOADSTEP(F[0], 0);
#pragma unroll
            for (int sx = 0; sx < 16; ++sx) { if (sx < 15) RET_LOADSTEP(F[(sx + 1) & 1], sx + 1); RET_MMASTEP(F[sx & 1], sx); __builtin_amdgcn_sched_barrier(0); }
#undef RET_LOADSTEP
#undef RET_MMASTEP
            { const float qdec = fexp2((float)(iq + 1) * lg2);
#pragma unroll
              for (int i = 0; i < 16; ++i) o[i] *= qdec; }
#pragma unroll
            for (int jj = 0; jj < 2; ++jj) if (jj < nj) { const int jb = j0 + jj;
#pragma unroll
                for (int r = 0; r < 16; ++r) { const int dl = iq2 - (jb * 32 + crow(r, hi2)); a[jj][r] = dl >= 0 ? a[jj][r] * fexp2((float)dl * lg2) : 0.f; }
#pragma unroll
                for (int s2 = 0; s2 < 2; ++s2) *(LAS bf16x8*)(lds + R_PX + ((IBT * (IBT + 1) / 2 + jb) * 2 + s2) * 1024 + lane * 16) = pack8(a[jj], s2); }
        }
        __syncthreads();
#pragma unroll
        for (int jb = 0; jb <= IBT; ++jb)
#pragma unroll
            for (int s2 = 0; s2 < 2; ++s2) { const bf16x8 pf = *(const LAS bf16x8*)(lds + R_PX + ((IBT * (IBT + 1) / 2 + jb) * 2 + s2) * 1024 + lane * 16);
                const bf16x8 vf = trfrag(lds + R_VI, R_VP, jb * 32 + 16 * s2, vb * 32, lane); o = MFMA32(vf, pf, o); if (s2) __builtin_amdgcn_sched_barrier(0); }
        { float ss = 0.f;
#pragma unroll
          for (int i = 0; i < 16; ++i) ss += o[i] * o[i];
          ss = pairsum(ss);
          if (hi == 0) HX[iq * 2 + vb] = ss;
          if (!DRY) {
          bf16_t* op = Vh + (size_t)(c * 128 + iq2) * 2048 + vb * 32;
#pragma unroll
          for (int j2 = 0; j2 < 2; ++j2) { u32x2 X, Y; X.x = cvtpk(o[8 * j2], o[8 * j2 + 1]); X.y = cvtpk(o[8 * j2 + 2], o[8 * j2 + 3]); Y.x = cvtpk(o[8 * j2 + 4], o[8 * j2 + 5]); Y.y = cvtpk(o[8 * j2 + 6], o[8 * j2 + 7]);
              *(u32x4*)(op + 8 * (2 * j2 + hi2)) = widen_pair(X, Y); } } }
        __builtin_amdgcn_sched_barrier(0);
        if (c < 15) {
#pragma unroll
            for (int s = 0; s < 16; ++s) qf[s] = *(const bf16x8*)(qp + 128 * 256 + 16 * s);
        }
#pragma unroll
        for (int i = 0; i < 16; ++i) { sacc[0][i] *= cdec; sacc[1][i] *= cdec; }
        { bf16x8 G[2][3];
          G[0][0] = trfrag(lds + R_KI, R_KP, 0, db * 32, lane); G[0][1] = trfrag(lds + R_VI2, R_VP, 0, 0, lane); G[0][2] = trfrag(lds + R_VI2, R_VP, 0, 32, lane);
#pragma unroll
          for (int s = 0; s < 8; ++s) {
              if (s < 7) { G[(s + 1) & 1][0] = trfrag(lds + R_KI, R_KP, 16 * (s + 1), db * 32, lane); G[(s + 1) & 1][1] = trfrag(lds + R_VI2, R_VP, 16 * (s + 1), 0, lane); G[(s + 1) & 1][2] = trfrag(lds + R_VI2, R_VP, 16 * (s + 1), 32, lane); }
              sacc[0] = MFMA32(G[s & 1][0], G[s & 1][1], sacc[0]); sacc[1] = MFMA32(G[s & 1][0], G[s & 1][2], sacc[1]); __builtin_amdgcn_sched_barrier(0); } }
    }
    __syncthreads();
    if (!DRY && tid < 128) hssq[((size_t)(b * T + 15 * 128 + tid) * 4 + h) * 8 + vs] = HX[tid * 2] + HX[tid * 2 + 1];
}

DI void cmp2_phase(const Params& P, int l, int tid, unsigned char* ws, unsigned char* ob, int bid, int G, LAS unsigned char* lds) {
    const int lane = tid & 63, wid = tid >> 6; const int half = G >> 1, j = bid >= half ? 1 : 0, lb = bid - j * half, nb = j ? G - half : half;
    const float* part = (const float*)(ob + OB_PART) + (size_t)j * 8192 * 256;
    const f32x4 bia = *(const f32x4*)((const float*)(ws + OFF_CB1) + (l * 2 + j) * 256 + lane * 4);
    const float* w2 = pin(P, I_CW2) + (size_t)(l * 2 + j) * 256 * 64;
    LAS float* W = (LAS float*)lds;
    __syncthreads();
#pragma unroll
    for (int i = 0; i < 8; ++i) { const int idx = (tid + 512 * i) * 4; *(LAS f32x4*)(W + idx) = *(const f32x4*)(w2 + idx); }
    __syncthreads();
    const float kg = pin(P, I_KG)[l * 192 + lane];
    for (int rr = lb * 8 + wid; rr < 8192; rr += nb * 8) {
        const int n = rr & 127;
        f32x4 hs = bia;
#pragma unroll
        for (int ks = 0; ks < 4; ++ks) hs = hs + *(const f32x4*)(part + ((size_t)ks * 2 * 8192 + rr) * 256 + lane * 4);
        const float h4[4] = {gelu_tanh(hs[0]), gelu_tanh(hs[1]), gelu_tanh(hs[2]), gelu_tanh(hs[3])};
        float acc0 = 0.f, acc1 = 0.f;
#pragma unroll 8
        for (int k4 = 0; k4 < 64; ++k4) {
            acc0 += __shfl(h4[0], k4) * W[(k4 * 4 + 0) * 64 + lane]; acc1 += __shfl(h4[1], k4) * W[(k4 * 4 + 1) * 64 + lane];
            acc0 += __shfl(h4[2], k4) * W[(k4 * 4 + 2) * 64 + lane]; acc1 += __shfl(h4[3], k4) * W[(k4 * 4 + 3) * 64 + lane]; }
        float acc = acc0 + acc1;
        if (j == 0) { const float ss = wave_sum(acc * acc) * (1.0f / 64.f); acc = acc * __builtin_amdgcn_rsqf(ss + EPS) * kg; }
        if (n == 127) acc = 0.f;
        bf16_t* dst = (bf16_t*)(ws + (j ? OFF_NVC : OFF_NKC)) + (size_t)rr * 64 + lane;
        *dst = (bf16_t)(cvtpk(acc, 0.f) & 0xffffu);
    }
}

constexpr int A_KP = 144;
constexpr int A_KT = 0, A_VT = 128 * A_KP, A_BIAS = 2 * 128 * A_KP, A_G4 = A_BIAS + 2304, A_EB = A_G4 + 8 * 32 * 33 * 4, A_IMP = A_EB + 8 * 32 * 33 * 4, A_SEL = A_IMP + 64 * 33 * 4, A_UNI = A_SEL + 256, A_END = A_UNI + 16;
static_assert(A_END <= LDS_BYTES, "attention LDS");

DI float max3f(float a, float b, float c) { return __builtin_fmaxf(__builtin_fmaxf(a, b), c); }
DI void attn_tile(LAS const unsigned char* KT, LAS const unsigned char* VT, const bf16x8 (&qf)[4], int kbase, int qpos, bool selbit, LAS const float* brow, float cb, int kind, float& mrun, float& lrun, f32x16 (&o)[2], int lane) {
    const int r32 = lane & 31, hi = lane >> 5;
    f32x16 s0, s1;
    { const f32x16 z = {0.f, 0.f, 0.f, 0.f, 0.f, 0.f, 0.f, 0.f, 0.f, 0.f, 0.f, 0.f, 0.f, 0.f, 0.f, 0.f};
      const bf16x8 a0 = *(const LAS bf16x8*)(KT + r32 * A_KP + (8 * hi) * 2), a1 = *(const LAS bf16x8*)(KT + (32 + r32) * A_KP + (8 * hi) * 2);
      s0 = MFMA32(a0, qf[0], z); s1 = MFMA32(a1, qf[0], z); }
#pragma unroll
    for (int s = 1; s < 4; ++s) { const bf16x8 a0 = *(const LAS bf16x8*)(KT + r32 * A_KP + (16 * s + 8 * hi) * 2), a1 = *(const LAS bf16x8*)(KT + (32 + r32) * A_KP + (16 * s + 8 * hi) * 2);
        s0 = MFMA32(a0, qf[s], s0); s1 = MFMA32(a1, qf[s], s1); }
    if (kind & 1) {
        const int dbase = qpos - kbase - 4 * hi;
        if (kind & 2) {
#pragma unroll
            for (int r = 0; r < 16; ++r) { const int d0 = dbase - ((r & 3) + 8 * (r >> 2)), d1 = d0 - 32;
                const float b0 = brow[min((unsigned)d0, 128u)], b1 = brow[min((unsigned)d1, 128u)];
                s0[r] = d0 >= 0 ? s0[r] + b0 : -1e30f; s1[r] = d1 >= 0 ? s1[r] + b1 : -1e30f; }
        } else {
#pragma unroll
            for (int r = 0; r < 16; ++r) { const int d0 = dbase - ((r & 3) + 8 * (r >> 2)), d1 = d0 - 32;
                s0[r] += brow[min((unsigned)d0, 128u)]; s1[r] += brow[min((unsigned)d1, 128u)]; }
        }
    } else if (kind & 2) {
        const int dbase = qpos - kbase - 4 * hi;
#pragma unroll
        for (int r = 0; r < 16; ++r) { const int d0 = dbase - ((r & 3) + 8 * (r >> 2)), d1 = d0 - 32; s0[r] = d0 < 512 ? s0[r] : -1e30f; s1[r] = d1 < 512 ? s1[r] : -1e30f; }
    }
    const float cadd = (kind & 1) ? 0.f : cb;
    float mx = fmaxf(s0[0], s1[0]);
#pragma unroll
    for (int r = 1; r < 16; ++r) mx = max3f(mx, s0[r], s1[r]);
    mx = selbit ? mx + cadd : -1e30f;
    mx = pairmax(mx);
    if (__any(mx > mrun + 8.0f)) { const float mnew = fmaxf(mrun, mx), alpha = fexp2(mrun - mnew); mrun = mnew; lrun *= alpha;
#pragma unroll
        for (int i = 0; i < 16; ++i) { o[0][i] *= alpha; o[1][i] *= alpha; } }
    const float t = selbit ? cadd - mrun : -1e30f;
    float rs = 0.f;
#pragma unroll
    for (int r = 0; r < 16; ++r) { s0[r] = fexp2(s0[r] + t); s1[r] = fexp2(s1[r] + t); rs += s0[r] + s1[r]; }
    lrun += rs;
    const bf16x8 p00 = pack8(s0, 0), p01 = pack8(s0, 1), p10 = pack8(s1, 0), p11 = pack8(s1, 1);
#pragma unroll
    for (int db = 0; db < 2; ++db) {
        o[db] = MFMA32(trfrag(VT, A_KP, 0, db * 32, lane), p00, o[db]);
        o[db] = MFMA32(trfrag(VT, A_KP, 16, db * 32, lane), p01, o[db]);
        o[db] = MFMA32(trfrag(VT, A_KP, 32, db * 32, lane), p10, o[db]);
        o[db] = MFMA32(trfrag(VT, A_KP, 48, db * 32, lane), p11, o[db]);
    }
}

template <int MODE>
DI void attn_branch(LAS unsigned char* lds, const bf16_t* Kg, const bf16_t* Vg, const bf16x8 (&qf)[4], int qpos, int qt, unsigned selmask, unsigned tiles, LAS const float* brow, float gate, LAS float* park, int tid, const u32x4 pk0, const u32x4 pv0) {
    asm volatile("" : "+v"(tid));
    const int lane = tid & 63;
    const float cb = brow[128];
    float mrun = -1e30f, lrun = 0.f; f32x16 o[2];
#pragma unroll
    for (int i = 0; i < 16; ++i) { o[0][i] = 0.f; o[1][i] = 0.f; }
    const int prow = tid >> 3, pc = tid & 7;
    unsigned rem = tiles; int buf = 0;
    int j = MODE == 0 ? __builtin_ctz(rem) : 31 - __builtin_clz(rem); rem &= ~(1u << j);
    { *(LAS u32x4*)(lds + A_KT + prow * A_KP + pc * 16) = pk0; *(LAS u32x4*)(lds + A_VT + prow * A_KP + pc * 16) = pv0; }
    __syncthreads();
    for (;;) {
        const bool more = rem != 0u; int jn = 0; u32x4 kk, vv;
        if (more) { jn = MODE == 0 ? __builtin_ctz(rem) : 31 - __builtin_clz(rem); rem &= ~(1u << jn); kk = *(const u32x4*)(Kg + (size_t)(jn * 64 + prow) * 64 + pc * 8); vv = *(const u32x4*)(Vg + (size_t)(jn * 64 + prow) * 64 + pc * 8); }
        const int kind = (j >= qt - 2 ? 1 : 0) | ((j == qt || (MODE == 1 && j == qt - 8)) ? 2 : 0);
        attn_tile(lds + A_KT + buf * 64 * A_KP, lds + A_VT + buf * 64 * A_KP, qf, j * 64, qpos, MODE == 1 ? true : (((selmask >> j) & 1u) != 0u), brow, cb, kind, mrun, lrun, o, lane);
        if (more) { const int nb = buf ^ 1; *(LAS u32x4*)(lds + A_KT + nb * 64 * A_KP + prow * A_KP + pc * 16) = kk; *(LAS u32x4*)(lds + A_VT + nb * 64 * A_KP + prow * A_KP + pc * 16) = vv; }
        __syncthreads();
        if (!more) break;
        j = jn; buf ^= 1;
    }
    const float lt = pairsum(lrun); const float sc = lt > 0.f ? gate * frcp(lt) : 0.f;
#pragma unroll
    for (int i = 0; i < 16; ++i) { park[i * 64] += o[0][i] * sc; park[(16 + i) * 64] += o[1][i] * sc; }
}

DI void nsa_unit(LAS unsigned char* lds, const Params& P, unsigned char* ws, int b, int g, int qt, int tid, bool build_bias) {
    { GAS unsigned char* wsg = (GAS unsigned char*)ws; asm volatile("" : "+s"(wsg)); ws = (unsigned char*)wsg; } asm volatile("" : "+v"(tid));
    const int lane = tid & 63, wid = __builtin_amdgcn_readfirstlane(tid >> 6), r32 = lane & 31, hi = lane >> 5;
    const int p = wid & 3, qs = wid >> 2, head = g * 4 + p, qpos = qt * 64 + qs * 32 + r32;
    const bf16_t* QN = (const bf16_t*)(ws + OFF_NQ); const bf16_t* KV = (const bf16_t*)(ws + OFF_NKV); const float* GATE = (const float*)(ws + OFF_NGATE);
    LAS float* BIAS = (LAS float*)(lds + A_BIAS); LAS float* G4 = (LAS float*)(lds + A_G4); LAS float* EB = (LAS float*)(lds + A_EB); LAS float* IMP = (LAS float*)(lds + A_IMP);
    LAS unsigned* SEL = (LAS unsigned*)(lds + A_SEL); LAS unsigned* UNI = (LAS unsigned*)(lds + A_UNI);
    __syncthreads();
    if (build_bias) for (int idx = tid; idx < 4 * 129; idx += NTHR) { const int pp = idx / 129, dist = idx - pp * 129; int bk;
        if (dist < 16) bk = dist; else { const float nf = (float)dist; int lg = 16 + (int)(logf(nf / 16.f) / 2.0794415416798357f * 16.f); bk = lg < 31 ? lg : 31; }
        BIAS[pp * 132 + dist] = pin(P, I_RELB)[bk * 16 + g * 4 + pp] * LOG2E; }
    if (tid == 0) UNI[0] = 0u;
    bf16x8 qf[4];
    { const bf16_t* qp = QN + ((size_t)(b * 16 + head) * T + qpos) * 64 + 8 * hi;
#pragma unroll
      for (int s = 0; s < 4; ++s) qf[s] = *(const bf16x8*)(qp + 16 * s); }
    const float* gp = GATE + (size_t)(b * T + qpos) * 48 + head; const float g0 = gp[0], g1 = gp[16], g2 = gp[32];
    const size_t tpo = (size_t)(tid >> 3) * 64 + (tid & 7) * 8;
    const bf16_t* KVb = KV + (size_t)(b * 4 + g) * T * 64;
    const u32x4 sk0 = *(const u32x4*)(KVb + 2 * KVSEC + tpo), sv0 = *(const u32x4*)(KVb + 3 * KVSEC + tpo);
    LAS const float* brow = BIAS + p * 132;
    LAS float* park = (LAS float*)(lds + A_G4) + wid * 2048 + lane;
    { const bf16_t* kc = (const bf16_t*)(ws + OFF_NKC) + (size_t)(b * 4 + g) * 128 * 64; const bf16_t* vc = (const bf16_t*)(ws + OFF_NVC) + (size_t)(b * 4 + g) * 128 * 64;
#pragma unroll
      for (int i = 0; i < 2; ++i) { const int pidx = tid + 512 * i, row = pidx >> 3, pc = pidx & 7;
          *(LAS u32x4*)(lds + A_KT + row * A_KP + pc * 16) = *(const u32x4*)(kc + row * 64 + pc * 8); *(LAS u32x4*)(lds + A_VT + row * A_KP + pc * 16) = *(const u32x4*)(vc + row * 64 + pc * 8); } }
    __syncthreads();
    f32x16 oc0, oc1;
    {
        f32x16 sc[4]; float mx = -1e30f;
#pragma unroll
        for (int t = 0; t < 4; ++t) {
#pragma unroll
            for (int i = 0; i < 16; ++i) sc[t][i] = 0.f;
#pragma unroll
            for (int s = 0; s < 4; ++s) { const bf16x8 a = *(const LAS bf16x8*)(lds + A_KT + (32 * t + r32) * A_KP + (16 * s + 8 * hi) * 2); sc[t] = MFMA32(a, qf[s], sc[t]); }
#pragma unroll
            for (int r = 0; r < 16; ++r) { const int n = 32 * t + crow(r, hi), dist = qpos - (16 * n + 31); const bool v = dist >= 0 && n < 127;
                sc[t][r] = v ? sc[t][r] + brow[min((unsigned)dist, 128u)] : -1e30f; mx = fmaxf(mx, sc[t][r]); }
        }
        mx = pairmax(mx);
        float rs = 0.f;
#pragma unroll
        for (int t = 0; t < 4; ++t)
#pragma unroll
            for (int r = 0; r < 16; ++r) { sc[t][r] = sc[t][r] > -1e29f ? fexp2(sc[t][r] - mx) : 0.f; rs += sc[t][r]; }
        rs = pairsum(rs);
        const float inv = rs > 0.f ? frcp(rs) : 0.f;
#pragma unroll
        for (int t = 0; t < 4; ++t)
#pragma unroll
            for (int r = 0; r < 16; ++r) sc[t][r] *= inv;
#pragma unroll
        for (int t = 0; t < 4; ++t)
#pragma unroll
            for (int rg = 0; rg < 4; ++rg) { const int jj = 8 * t + 2 * rg + hi; G4[(wid * 32 + r32) * 33 + jj] = (sc[t][4 * rg] + sc[t][4 * rg + 1]) + (sc[t][4 * rg + 2] + sc[t][4 * rg + 3]); EB[(wid * 32 + r32) * 33 + jj] = sc[t][4 * rg + 3]; }
        f32x16 o[2];
#pragma unroll
        for (int i = 0; i < 16; ++i) { o[0][i] = 0.f; o[1][i] = 0.f; }
#pragma unroll
        for (int t = 0; t < 4; ++t)
#pragma unroll
            for (int s2 = 0; s2 < 2; ++s2) { const bf16x8 pf = pack8(sc[t], s2);
                o[0] = MFMA32(trfrag(lds + A_VT, A_KP, 32 * t + 16 * s2, 0, lane), pf, o[0]); o[1] = MFMA32(trfrag(lds + A_VT, A_KP, 32 * t + 16 * s2, 32, lane), pf, o[1]); }
#pragma unroll
        for (int i = 0; i < 16; ++i) { o[0][i] *= g0; o[1][i] *= g0; }
        oc0 = o[0]; oc1 = o[1];
    }
    __syncthreads();
#pragma unroll
    for (int i = 0; i < 4; ++i) { const int idx = tid + 512 * i, q = idx >> 5, jj = idx & 31, w0 = (q >> 5) * 4, ql = q & 31; float s = 0.f;
#pragma unroll
        for (int pp = 0; pp < 4; ++pp) { s += G4[((w0 + pp) * 32 + ql) * 33 + jj]; if (jj > 0) s += EB[((w0 + pp) * 32 + ql) * 33 + jj - 1]; }
        IMP[q * 33 + jj] = s; }
    __syncthreads();
    { const int cur = qt, q = tid >> 3, sub = tid & 7; unsigned mask;
        if (cur < 8) mask = (2u << cur) - 1u;
        else { mask = 1u | (1u << cur) | (1u << (cur - 1));
            float iv[4];
#pragma unroll
            for (int e = 0; e < 4; ++e) iv[e] = IMP[q * 33 + sub * 4 + e];
#pragma unroll 1
            for (int it = 0; it < 5; ++it) { float bv = -3.0e38f; int best = 99;
#pragma unroll
                for (int e = 0; e < 4; ++e) { const int jj = sub * 4 + e; const bool ok = jj >= 1 && jj <= cur - 2 && !((mask >> jj) & 1u) && iv[e] > bv; bv = ok ? iv[e] : bv; best = ok ? jj : best; }
#pragma unroll
                for (int x = 1; x < 8; x <<= 1) { const float ov = __shfl_xor(bv, x); const int oi = __shfl_xor(best, x); const bool tk = ov > bv || (ov == bv && oi < best); bv = tk ? ov : bv; best = tk ? oi : best; }
                mask |= 1u << best; } }
        if (sub == 0) { SEL[q] = mask; atomicOr((unsigned*)UNI, mask); } }
    __syncthreads();
    const unsigned selmask = SEL[qs * 32 + r32], uni = UNI[0];
#pragma unroll
    for (int i = 0; i < 16; ++i) { park[i * 64] = oc0[i]; park[(16 + i) * 64] = oc1[i]; }
    u32x4 wk0, wv0;
    { GAS unsigned char* wsg = (GAS unsigned char*)ws; asm volatile("" : "+s"(wsg)); const bf16_t* KVs = (const bf16_t*)((unsigned char*)wsg + OFF_NKV) + (size_t)(b * 4 + g) * T * 64;
      wk0 = *(const u32x4*)(KVs + 4 * KVSEC + (size_t)qt * 4096 + tpo); wv0 = *(const u32x4*)(KVs + 5 * KVSEC + (size_t)qt * 4096 + tpo);
      attn_branch<0>(lds, KVs + 2 * KVSEC, KVs + 3 * KVSEC, qf, qpos, qt, selmask, uni, brow, g1, park, tid, sk0, sv0); }
    { GAS unsigned char* wsg = (GAS unsigned char*)ws; asm volatile("" : "+s"(wsg)); const bf16_t* KVs = (const bf16_t*)((unsigned char*)wsg + OFF_NKV) + (size_t)(b * 4 + g) * T * 64;
      const int lo = qt >= 8 ? qt - 8 : 0; const unsigned wt = ((2u << qt) - 1u) & ~((1u << lo) - 1u);
      attn_branch<1>(lds, KVs + 4 * KVSEC, KVs + 5 * KVSEC, qf, qpos, qt, 0u, wt, brow, g2, park, tid, wk0, wv0); }
    { GAS unsigned char* wsg = (GAS unsigned char*)ws; asm volatile("" : "+s"(wsg)); ws = (unsigned char*)wsg; }
    bf16_t* op = (bf16_t*)((unsigned char*)(GAS unsigned char*)P.out + OB_NO) + (size_t)(b * T + qpos) * D + head * 64;
#pragma unroll
    for (int db = 0; db < 2; ++db)
#pragma unroll
        for (int j2 = 0; j2 < 2; ++j2) { const LAS float* pk = park + (db * 16 + 8 * j2) * 64; u32x2 X, Y;
            X.x = cvtpk(pk[0], pk[64]); X.y = cvtpk(pk[128], pk[192]); Y.x = cvtpk(pk[256], pk[320]); Y.y = cvtpk(pk[384], pk[448]);
            *(u32x4*)(op + db * 32 + 8 * (2 * j2 + hi)) = widen_pair(X, Y); }
}


constexpr size_t OFF_CTL = 7 * MiB + 512 * 1024;
constexpr int CTL_BYTES = 16384;
constexpr int LDS_BARST = LDS_BYTES - 64;
#define XB_TMO      128
#define XB_XCNT(j)  (256  + 64 * (j))
#define XB_XSUB(j)  (1280 + 64 * (j))
#define XB_XGEN(j)  (2304 + 64 * (j))
#define XB_TOP      3328
#define XB_TOPGEN   3392
#define XB_SPIN_CAP (1u << 22)
DI unsigned xb_ld(unsigned* p)              { return __hip_atomic_load(p, __ATOMIC_RELAXED, __HIP_MEMORY_SCOPE_AGENT); }
DI unsigned xb_add(unsigned* p, unsigned v) { return __hip_atomic_fetch_add(p, v, __ATOMIC_RELAXED, __HIP_MEMORY_SCOPE_AGENT); }
DI unsigned xb_xcc_id() { return (unsigned)__builtin_amdgcn_s_getreg((3 << 11) | 20) & 0xFu; }
#define XB_SPIN(cond, bar) do { unsigned _sp = 0; while (cond) { __builtin_amdgcn_s_sleep(1); \
    if ((++_sp & 255u) == 0u) { if (xb_ld(&(bar)[XB_TMO])) break; if (_sp > XB_SPIN_CAP) { atomicAdd(&(bar)[XB_TMO], 1u); break; } } } } while (0)
struct XcdBarrier { unsigned* bar; unsigned x; volatile LAS unsigned* st; };
DI XcdBarrier xcd_barrier_post(unsigned* bar, volatile LAS unsigned* st) {
    XcdBarrier b; b.bar = bar; b.x = xb_xcc_id(); b.st = st;
    if (threadIdx.x == 0) (void)xb_add(&bar[XB_XCNT(b.x)], 1u);
    return b;
}
DI void xcd_barrier_complete(unsigned* bar, unsigned x, unsigned& nloc, unsigned& nx) {
    const unsigned G = gridDim.x * gridDim.y * gridDim.z;
    unsigned sum, cnt, mine, sp = 0u;
    for (;;) {
        sum = 0u; cnt = 0u; mine = 0u;
#pragma unroll
        for (unsigned j = 0; j < 16; ++j) { const unsigned c = xb_ld(&bar[XB_XCNT(j)]); sum += c; cnt += (c > 0u) ? 1u : 0u; mine = (j == x) ? c : mine; }
        if (sum == G) break;
        __builtin_amdgcn_s_sleep(1);
        if ((++sp & 255u) == 0u) { if (xb_ld(&bar[XB_TMO])) break; if (sp > XB_SPIN_CAP) { atomicAdd(&bar[XB_TMO], 1u); break; } }
    }
    nloc = mine > 0u ? mine : 1u; nx = cnt > 0u ? cnt : 1u;
}
DI void xcd_barrier(const XcdBarrier& b) {
    asm volatile("s_waitcnt vmcnt(0)" ::: "memory");
    __syncthreads();
    if (threadIdx.x == 0) {
        unsigned* bar = b.bar;
        __builtin_amdgcn_s_waitcnt(0);
        unsigned nloc = b.st[0], nx = b.st[1];
        if (nloc == 0u) { xcd_barrier_complete(bar, b.x, nloc, nx); b.st[0] = nloc; b.st[1] = nx; }
        const unsigned old = xb_add(&bar[XB_XSUB(b.x)], 1u);
        const unsigned gen = old / nloc;
        if (old + 1u == (gen + 1u) * nloc) {
            __builtin_amdgcn_fence(__ATOMIC_RELEASE, "agent");
            asm volatile("s_waitcnt vmcnt(0)" ::: "memory");
            const unsigned og = xb_add(&bar[XB_TOP], 1u);
            const unsigned tg = og / nx;
            if (og + 1u == (tg + 1u) * nx) xb_add(&bar[XB_TOPGEN], 1u);
            else XB_SPIN(xb_ld(&bar[XB_TOPGEN]) == tg, bar);
            __builtin_amdgcn_fence(__ATOMIC_ACQUIRE, "agent");
            xb_add(&bar[XB_XGEN(b.x)], 1u);
            asm volatile("s_waitcnt vmcnt(0)" ::: "memory");
        } else {
            XB_SPIN(xb_ld(&bar[XB_XGEN(b.x)]) == gen, bar);
            __builtin_amdgcn_fence(__ATOMIC_ACQUIRE, "agent");
            asm volatile("s_waitcnt vmcnt(0)" ::: "memory");
        }
    }
    __syncthreads();
}

#ifndef EN_MASK
#define EN_MASK 0xffff
#endif
#define EN(b) ((EN_MASK >> (b)) & 1)
#ifndef PROBE_ATTN
#define PROBE_ATTN 0
#endif
#ifndef PROBE_RET
#define PROBE_RET 0
#endif
#ifndef PROBE_GU
#define PROBE_GU 0
#endif
#ifndef PROBE_SYNC
#define PROBE_SYNC 0
#endif
#ifndef PROBE_PRO
#define PROBE_PRO 0
#endif
constexpr int NPHASE = 35;
__global__ void __launch_bounds__(NTHR, 2) fwd_kernel(Params P) {
    extern __shared__ __attribute__((aligned(16))) unsigned char lds_raw[];
    LAS unsigned char* lds = (LAS unsigned char*)lds_raw;
    if (threadIdx.x < 16) ((LAS unsigned*)(lds + LDS_BARST))[threadIdx.x] = 0u;
    __syncthreads();
    (void)xcd_barrier_post((unsigned*)(P.ws + OFF_CTL), (volatile LAS unsigned*)(lds + LDS_BARST));
    const int wv0 = __builtin_amdgcn_readfirstlane(threadIdx.x >> 6);
    for (int ph = P.ph_lo; ph < P.ph_hi; ++ph) {
        unsigned allm = ~0u; asm volatile("" : "+s"(allm));
        int tid = wv0 * 64 + (int)__builtin_amdgcn_mbcnt_hi(allm, __builtin_amdgcn_mbcnt_lo(allm, 0u)); asm volatile("" : "+v"(tid));
        GAS unsigned char* wsg = (GAS unsigned char*)P.ws; asm volatile("" : "+s"(wsg)); unsigned char* ws = (unsigned char*)wsg;
        int bid = blockIdx.x, G = gridDim.x; asm volatile("" : "+s"(bid), "+s"(G));
        GAS unsigned char* obg = (GAS unsigned char*)P.out; asm volatile("" : "+s"(obg)); unsigned char* ob = (unsigned char*)obg;
        float* ssq = (float*)(ws + OFF_SSQ); bf16_t* xb = (bf16_t*)(ws + OFF_XB);
        int layer = -1, kind = -1;
        if (ph > 0) { int q = ph - 1; for (int l = 0; l < DEPTH; ++l) { const int np = (l & 1) ? 9 : 8; if (q < np) { layer = l; kind = q; break; } q -= np; } }
        const bool is_nsa = layer & 1; const int j = layer >> 1;
        const int nmix = is_nsa ? 5 : 4;
        int gk = -1;
        int which = 0;
        if (ph == 0) gk = -2;
        else if (kind == 0) { gk = 0; which = 0; } else if (kind == 1) { gk = 1; which = 0; }
        else if (kind == 2 + nmix) { gk = 0; which = 1; } else if (kind == 3 + nmix) { gk = 1; which = 1; }
        else if (kind == 1 + nmix) gk = 2;
        else gk = 10 + (kind - 2);
        if (gk == -2) { if (EN(0)) prologue(P, lds, tid, ws, bid, G); }
        else if (gk == 0) {
            pg8::Gemm g{xb, (const bf16_t*)(ws + OFF_WFFN + (size_t)(layer * 2 + which) * FFN_SZ), M, NGU, D, D}; pg8::StaticOrder S; S.init(M, NGU, G, bid);
            EpiSwiglu E{ssq, (bf16_t*)(ws + OFF_ACT)}; if (EN(1)) pg8::gemm_phase(lds, g, S, E, tid);
        } else if (gk == 1 || gk == 2) {
            const bf16_t* A; const bf16_t* Bt; int K; float alpha;
            if (gk == 1) { A = (const bf16_t*)(ws + OFF_ACT); Bt = (const bf16_t*)(ws + OFF_WFFN + (size_t)(layer * 2 + which) * FFN_SZ + WGU_SZ); K = DFF; alpha = 0.5f; }
            else if (!is_nsa) { A = (const bf16_t*)(ws + OFF_RVO); Bt = (const bf16_t*)(ws + OFF_WRET + (size_t)j * RET_SZ + RETIN_SZ); K = 2048; alpha = 1.f; }
            else { A = (const bf16_t*)(ob + OB_NO); Bt = (const bf16_t*)(ws + OFF_WNSA + (size_t)j * NSA_SZ + NSAIN_SZ); K = D; alpha = 1.f; }
            pg8::Gemm g{A, Bt, M, D, K, K}; pg8::StaticOrder S; S.init(M, D, G, bid);
            EpiResid E{(layer == 0 && gk == 1 && which == 0) ? pin(P, I_X) : (const float*)nullptr, (layer == DEPTH - 1 && gk == 1 && which == 1) ? (float*)ob : (float*)nullptr, xb, (unsigned char*)(ws + OFF_XLO), ssq, alpha, (LAS float*)(lds + EPI_LDS)}; if (EN(2)) pg8::gemm_phase(lds, g, S, E, tid);
        } else if (!is_nsa) {
            const bf16_t* Win = (const bf16_t*)(ws + OFF_WRET + (size_t)j * RET_SZ);
            if (gk == 10) { pg8::Gemm g{xb, Win, M, 4096, D, D}; pg8::StaticOrder S; S.init(M, 4096, G, bid);
                EpiRetQKV E{ssq, (const float*)(ws + OFF_COS), (const float*)(ws + OFF_SIN), (bf16_t*)(ob + OB_RQ), (bf16_t*)(ob + OB_RK), (bf16_t*)(ws + OFF_RVO)}; if (EN(3)) pg8::gemm_phase(lds, g, S, E, tid); }
            else if (gk == 11) { const int wv = __builtin_amdgcn_readfirstlane(tid >> 6), ibw = wv < 4 ? wv : 7 - wv;
#define RET_ARGS lds, (const bf16_t*)(ob + OB_RQ), (const bf16_t*)(ob + OB_RK), (bf16_t*)(ws + OFF_RVO), (float*)(ws + OFF_HSSQ), u >> 5, (u >> 3) & 3, u & 7, tid
                if (wv >= 4) __builtin_amdgcn_s_setprio(1);
                if (EN(4)) for (int uu = bid; uu < 512; uu += G) {
                    int u = uu; if (G == 256) { const int kk = uu >> 8, bb = uu & 255; u = ((kk * 32 + (bb & 7) * 4 + (bb >> 6)) << 3) | ((bb >> 3) & 7); }
                    if (wv < 4) { if (ibw == 0) ret_unit<0, 0, false>(RET_ARGS); else if (ibw == 1) ret_unit<1, 0, false>(RET_ARGS); else if (ibw == 2) ret_unit<2, 0, false>(RET_ARGS); else ret_unit<3, 0, false>(RET_ARGS); }
                    else { if (ibw == 0) ret_unit<0, 1, false>(RET_ARGS); else if (ibw == 1) ret_unit<1, 1, false>(RET_ARGS); else if (ibw == 2) ret_unit<2, 1, false>(RET_ARGS); else ret_unit<3, 1, false>(RET_ARGS); } }
                __builtin_amdgcn_s_setprio(0); }
            else { pg8::Gemm g{xb, Win + (size_t)4096 * D, M, 2048, D, D}; pg8::StaticOrder S; S.init(M, 2048, G, bid);
                EpiRetG E{ssq, (const float*)(ws + OFF_HSSQ), (bf16_t*)(ws + OFF_RVO)}; if (EN(5)) pg8::gemm_phase(lds, g, S, E, tid); }
        } else {
            const bf16_t* Win = (const bf16_t*)(ws + OFF_WNSA + (size_t)j * NSA_SZ);
            if (gk == 10) { pg8::Gemm g{xb, Win, M, NSA_NPAD, D, D}; pg8::StaticOrder S; S.init(M, NSA_NPAD, G, bid);
                EpiNsaIn E{ssq, pin(P, I_QG) + j * 64, pin(P, I_KG) + j * 192, (bf16_t*)(ws + OFF_NQ), (bf16_t*)(ws + OFF_NKV), (float*)(ws + OFF_NGATE)}; if (EN(6)) pg8::gemm_phase(lds, g, S, E, tid); }
            else if (gk == 11) {
                for (int idx = 0; idx < 8; ++idx) { const int jj = idx & 1, ks = idx >> 1;
                    pg8::Gemm g{(const bf16_t*)(ws + OFF_NKV) + (size_t)jj * KVSEC + ks * 512, Win + (NSAIN_SZ + NSAOUT_SZ + (size_t)jj * NSAW1_SZ) / 2 + ks * 512, 8192, 256, 512, 1024, 2048};
                    pg8::StaticOrder S; S.init(8192, 256, G, (bid + idx * (G / 8)) % G);
                    EpiCmp1 E{(float*)(ob + OB_PART) + (size_t)idx * 8192 * 256}; if (EN(7)) pg8::gemm_phase(lds, g, S, E, tid); }
            }
            else if (gk == 12) { if (EN(8)) cmp2_phase(P, j, tid, ws, ob, bid, G, lds); }
            else { int prev_g = -1; if (tid >= 256) __builtin_amdgcn_s_setprio(1);
                if (EN(9)) for (int u = bid; u < 2048; u += G) { int rnd = u >> 8, sub = (u >> 6) & 3, qt = 31 - 4 * rnd - ((rnd & 1) ? 3 - sub : sub), bg = u & 63;
                if (G == 256) { const int slot = bid >> 3, a = (slot + 8 * (rnd >> 1)) & 31; bg = rnd * 8 + (bid & 7); qt = (rnd & 1) ? 31 - a : a; }
                nsa_unit(lds, P, ws, bg >> 2, bg & 3, qt, tid, (bg & 3) != prev_g); prev_g = bg & 3; }
                __builtin_amdgcn_s_setprio(0); }
        }
        if (ph + 1 < P.ph_hi) { if (ph == 0) cg::this_grid().sync(); else { XcdBarrier xbar; xbar.bar = (unsigned*)(ws + OFF_CTL); xbar.x = xb_xcc_id(); xbar.st = (volatile LAS unsigned*)(lds + LDS_BARST); xcd_barrier(xbar); } }
    }
}

extern "C" void kernel_launch(void* const* d_in, const int* in_sizes, int n_in, void* d_out, int out_size, void* d_ws, size_t ws_size, hipStream_t stream) {
    static int grid = 0;
    if (grid == 0) {
        if (n_in != 18 || out_size != M * D || ws_size < WS_NEED) { fprintf(stderr, "kernel_launch: unexpected shapes n_in %d out %d ws %zu\n", n_in, out_size, ws_size); grid = -1; return; }
        int dev = 0, cus = 0, per_cu = 0;
        hipGetDevice(&dev); hipDeviceGetAttribute(&cus, hipDeviceAttributeMultiprocessorCount, dev);
        hipFuncSetAttribute((const void*)fwd_kernel, hipFuncAttributeMaxDynamicSharedMemorySize, LDS_BYTES);
        hipOccupancyMaxActiveBlocksPerMultiprocessor(&per_cu, (const void*)fwd_kernel, NTHR, LDS_BYTES);
        if (per_cu < 1) per_cu = 1;
        grid = cus * per_cu;
        (void)hipGetLastError();
    }
    if (grid < 0) return;
    Params p{};
    for (int i = 0; i < 18; ++i) p.in[i] = (const float*)d_in[i];
    p.out = (float*)d_out; p.ws = (unsigned char*)d_ws;
    (void)hipMemsetAsync((char*)d_ws + OFF_CTL, 0, CTL_BYTES, stream);
#if MK_ONE_LAUNCH
    p.ph_lo = 0; p.ph_hi = NPHASE;
    void* args[] = {&p};
    hipError_t e = hipLaunchCooperativeKernel((const void*)fwd_kernel, dim3(grid), dim3(NTHR), args, LDS_BYTES, stream);
    if (e != hipSuccess) fprintf(stderr, "cooperative launch failed: %s (grid %d)\n", hipGetErrorString(e), grid);
#else
    for (int ph = 0; ph < NPHASE; ++ph) { p.ph_lo = ph; p.ph_hi = ph + 1; hipLaunchKernelGGL(fwd_kernel, dim3(grid), dim3(NTHR), LDS_BYTES, stream, p); }
#endif
}
```

```cpp
#include <hip/hip_runtime.h>
#include <hip/hip_cooperative_groups.h>
#include <cstdio>
#include <cstdint>
namespace cg = cooperative_groups;

#ifndef MK_ONE_LAUNCH
#define MK_ONE_LAUNCH 1
#endif

#define DI __device__ __forceinline__
#define LAS __attribute__((address_space(3)))
typedef unsigned short bf16_t;
typedef short bf16x8 __attribute__((ext_vector_type(8)));
typedef short s16x4 __attribute__((ext_vector_type(4)));
typedef float f32x2 __attribute__((ext_vector_type(2)));
typedef float f32x4 __attribute__((ext_vector_type(4)));
typedef float f32x16 __attribute__((ext_vector_type(16)));
typedef unsigned u32x2 __attribute__((ext_vector_type(2)));
typedef unsigned u32x4 __attribute__((ext_vector_type(4)));
typedef __bf16 bf16x2_t __attribute__((ext_vector_type(2)));

constexpr int NB = 16, T = 2048, D = 1024, M = NB * T, DFF = 2816, NGU = 2 * DFF;
constexpr int DEPTH = 4;
constexpr float EPS = 1e-6f;
constexpr float LOG2E = 1.4426950408889634f;
constexpr int NSA_NPAD = 2816;
constexpr int NTHR = 512;

constexpr size_t MiB = 1u << 20;
constexpr size_t OFF_SSQ = 0;
constexpr size_t OFF_HSSQ = 1 * MiB;
constexpr size_t OFF_COS = 5 * MiB, OFF_SIN = 6 * MiB;
constexpr size_t OFF_CB1 = 7 * MiB;
constexpr size_t OFF_W = 8 * MiB;
constexpr size_t WGU_SZ = (size_t)NGU * D * 2, WD_SZ = (size_t)D * DFF * 2, FFN_SZ = WGU_SZ + WD_SZ;
constexpr size_t OFF_WFFN = OFF_W;
constexpr size_t RETIN_SZ = (size_t)6144 * D * 2, RETOUT_SZ = (size_t)D * 2048 * 2, RET_SZ = RETIN_SZ + RETOUT_SZ;
constexpr size_t OFF_WRET = OFF_WFFN + 8 * FFN_SZ;
constexpr size_t NSAIN_SZ = (size_t)NSA_NPAD * D * 2, NSAOUT_SZ = (size_t)D * D * 2, NSAW1_SZ = (size_t)256 * 2048 * 2, NSA_SZ = NSAIN_SZ + NSAOUT_SZ + 2 * NSAW1_SZ;
constexpr size_t OFF_WNSA = OFF_WRET + 2 * RET_SZ;
constexpr size_t OFF_WEND = OFF_WNSA + 2 * NSA_SZ;
constexpr size_t OFF_XB = 192 * MiB;
static_assert(OFF_WEND <= OFF_XB, "weights fit");
constexpr size_t OFF_LOC = 256 * MiB;
constexpr size_t OFF_ACT = OFF_LOC;
constexpr size_t OFF_RVO = OFF_LOC;
constexpr size_t OB_RQ = 0, OB_RK = 64 * MiB;
constexpr size_t OB_NO = 0, OB_PART = 64 * MiB;
constexpr size_t OFF_XLO = OFF_LOC + 192 * MiB;
constexpr size_t OFF_NQ = OFF_LOC;
constexpr size_t OFF_NKV = OFF_LOC + 64 * MiB;
constexpr size_t KVSEC = (size_t)NB * 4 * T * 64;
constexpr size_t OFF_NGATE = OFF_LOC + 160 * MiB;
constexpr size_t OFF_NKC = OFF_LOC + 166 * MiB, OFF_NVC = OFF_LOC + 167 * MiB;
constexpr size_t WS_NEED = 512 * MiB;

constexpr int LDS_BYTES = 163840;
constexpr int EPI_LDS = 131072;

DI unsigned cvtpk(float lo, float hi) { f32x2 v = {lo, hi}; bf16x2_t b = __builtin_convertvector(v, bf16x2_t); return __builtin_bit_cast(unsigned, b); }
DI float bf2f(unsigned short h) { return __uint_as_float(((unsigned)h) << 16); }
DI float bflo(unsigned u) { return __uint_as_float(u << 16); }
DI float bfhi(unsigned u) { return __uint_as_float(u & 0xffff0000u); }
DI float fexp2(float x) { return __builtin_amdgcn_exp2f(x); }
DI float frcp(float x) { return __builtin_amdgcn_rcpf(x); }
DI float sigmoidf_(float x) { return frcp(1.0f + fexp2(-x * LOG2E)); }
DI float siluf_(float x) { return x * sigmoidf_(x); }
DI float pairsum(float v) { auto rr = __builtin_amdgcn_permlane32_swap(__float_as_uint(v), __float_as_uint(v), false, false); return __uint_as_float(rr[0]) + __uint_as_float(rr[1]); }
DI float pairmax(float v) { auto rr = __builtin_amdgcn_permlane32_swap(__float_as_uint(v), __float_as_uint(v), false, false); return fmaxf(__uint_as_float(rr[0]), __uint_as_float(rr[1])); }
DI float wave_sum(float v) {
#pragma unroll
    for (int o = 1; o < 64; o <<= 1) v += __shfl_xor(v, o);
    return v;
}
DI u32x4 widen_pair(u32x2 X, u32x2 Y) {
    auto r0 = __builtin_amdgcn_permlane32_swap(X.x, Y.x, false, false); auto r1 = __builtin_amdgcn_permlane32_swap(X.y, Y.y, false, false);
    return (u32x4){r0[0], r1[0], r0[1], r1[1]};
}
DI int crow(int r, int hi) { return (r & 3) + 8 * (r >> 2) + 4 * hi; }
#define MFMA32(a, b, c) __builtin_amdgcn_mfma_f32_32x32x16_bf16((a), (b), (c), 0, 0, 0)
typedef short v4i16_t __attribute__((ext_vector_type(4)));
DI s16x4 trread(LAS const unsigned char* p) { return __builtin_bit_cast(s16x4, __builtin_amdgcn_ds_read_tr16_b64_v4i16((LAS v4i16_t*)p)); }
DI bf16x8 trfrag(LAS const unsigned char* img, int pitch, int row0, int col0, int lane) {
    const int hi = lane >> 5, q = (lane & 15) >> 2, p = lane & 3, blk = (lane >> 4) & 1;
    LAS const unsigned char* a = img + (row0 + 4 * hi + q) * pitch + (col0 + 16 * blk) * 2 + 8 * p;
    const s16x4 lo = trread(a), hh = trread(a + 8 * pitch);
    return (bf16x8){lo[0], lo[1], lo[2], lo[3], hh[0], hh[1], hh[2], hh[3]};
}
DI bf16x8 pack8(const f32x16& x, int s) {
    u32x4 p; p.x = cvtpk(x[8 * s], x[8 * s + 1]); p.y = cvtpk(x[8 * s + 2], x[8 * s + 3]); p.z = cvtpk(x[8 * s + 4], x[8 * s + 5]); p.w = cvtpk(x[8 * s + 6], x[8 * s + 7]);
    return __builtin_bit_cast(bf16x8, p);
}

namespace pg8 {
constexpr int BM = 256, BK = 64, HALF = 128, HTB = HALF * BK * 2, NXCD = 8, WGM = 8;
__host__ __device__ __forceinline__ int lds_byte(int r, int c) { const int st = (r >> 4) * 2 + (c >> 5), rr = r & 15, cc = c & 31, ob = rr * 64 + cc * 2; return st * 1024 + (ob ^ (((ob >> 9) & 1) << 5)); }
__host__ __device__ __forceinline__ void stage_rc(int b, int& R, int& C) { const int st = b / 1024, sb = b % 1024, swz = sb ^ (((sb >> 9) & 1) << 5); R = (st >> 1) * 16 + swz / 64; C = (st & 1) * 32 + (swz % 64) / 2; }
__host__ __device__ __forceinline__ int perm32(int rho) { const int n = rho >> 4, i = rho & 15; return 8 * (i >> 2) + 4 * n + (i & 3); }
struct Unit { int pm, pn; };
struct Gemm { const bf16_t* A; const bf16_t* Bt; int M, N, K, lda, ldb; };
struct StaticOrder {
    int nM, nN, nwg, G, c;
    __device__ void init(int M_, int N_, int G_, int c_) { nM = M_ / BM; nN = N_ / BM; nwg = nM * nN; G = G_; c = c_; }
    __device__ bool next(int i, Unit& u) const {
        const long L = (long)i * G + c; if (L >= nwg) return false;
        int wgid = (int)L; { const int q = nwg / NXCD, r = nwg % NXCD, xcd = wgid % NXCD, off = wgid / NXCD; wgid = (xcd < r ? xcd * (q + 1) : r * (q + 1) + (xcd - r) * q) + off; }
        const int nig = WGM * nN, gid = wgid / nig, fm = gid * WGM, gsz = (nM - fm) < WGM ? (nM - fm) : WGM;
        u.pm = fm + ((wgid % nig) % gsz); u.pn = (wgid % nig) / gsz; return true;
    }
};
template <class Epi>
__device__ __forceinline__ void gemm_phase(LAS unsigned char* lds, const Gemm g, const StaticOrder& S, const Epi& E, const int tid) {
    const int wid = __builtin_amdgcn_readfirstlane(tid >> 6), lane = tid & 63, wr = wid >> 2, wc = wid & 3, fr = lane & 15, fq = lane >> 4;
    const int K = g.K, nt = K / BK, ldb = g.ldb ? g.ldb : K;
    unsigned voffA[2], voffB[2];
#pragma unroll
    for (int i = 0; i < 2; ++i) { int R, C; stage_rc(tid * 16 + i * 8192, R, C); const int Rb = Epi::PERM ? ((R & ~31) + perm32(R & 31)) : R;
        voffA[i] = (unsigned)(R * g.lda + C) * 2u; voffB[i] = (unsigned)(Rb * ldb + C) * 2u; }
    const size_t kstep = (size_t)(BK * 2);
    const size_t hstepA = (size_t)HALF * g.lda * 2, hstepB = (size_t)HALF * ldb * 2;
    const size_t tstepA = 2 * hstepA, tstepB = 2 * hstepB;
    const unsigned ldsw = (unsigned)wid * 1024u;
    const int aoff = lds_byte(wr * 64 + fr, fq * 8), boff = lds_byte(wc * 32 + fr, fq * 8);
#define PG8_SA(b, h) (((b) * 2 + (h)) * HTB)
#define PG8_SB(b, h) ((4 + (b) * 2 + (h)) * HTB)
#define PG8_STAGE(bufoff, gbase, voff) do { _Pragma("unroll") for (int _i = 0; _i < 2; ++_i) \
        __builtin_amdgcn_global_load_lds((const unsigned*)((const char*)(gbase) + (voff)[_i]), (LAS unsigned*)(lds + (bufoff) + ldsw + _i * 8192), 16, 0, 0); } while (0)
#define PG8_LDA(dst, b, h) do { _Pragma("unroll") for (int m = 0; m < 4; ++m) _Pragma("unroll") for (int k = 0; k < 2; ++k) dst[m][k] = *(const LAS bf16x8*)(lds + PG8_SA(b, h) + aoff + m * 2048 + k * 1024); } while (0)
#define PG8_LDB(dst, b, h) do { _Pragma("unroll") for (int n = 0; n < 2; ++n) _Pragma("unroll") for (int k = 0; k < 2; ++k) dst[n][k] = *(const LAS bf16x8*)(lds + PG8_SB(b, h) + boff + n * 2048 + k * 1024); } while (0)
#define PG8_MMA(ai, bj, At, Bt) do { __builtin_amdgcn_s_setprio(1); _Pragma("unroll") for (int m = 0; m < 4; ++m) _Pragma("unroll") for (int n = 0; n < 2; ++n) _Pragma("unroll") for (int k = 0; k < 2; ++k) \
        acc[ai][bj][m][n] = __builtin_amdgcn_mfma_f32_16x16x32_bf16(Bt[n][k], At[m][k], acc[ai][bj][m][n], 0, 0, 0); __builtin_amdgcn_s_setprio(0); } while (0)
#define PG8_WAIT_V(n) asm volatile("s_waitcnt vmcnt(" #n ")" ::: "memory")
#define PG8_WAIT_L(n) asm volatile("s_waitcnt lgkmcnt(" #n ")" ::: "memory")
#define PG8_BAR __builtin_amdgcn_s_barrier()
#define PG8_SCHED __builtin_amdgcn_sched_barrier(0)
    Unit cur, nxt; int ui = 0;
    if (!S.next(0, cur)) return;
    f32x4 acc[2][2][4][2];
#pragma unroll
    for (int a = 0; a < 2; ++a)
#pragma unroll
        for (int b = 0; b < 2; ++b)
#pragma unroll
            for (int m = 0; m < 4; ++m)
#pragma unroll
                for (int n = 0; n < 2; ++n) acc[a][b][m][n] = (f32x4){0.f, 0.f, 0.f, 0.f};
    bf16x8 At[4][2], B0[2][2], B1[2][2];
    float rs[8];
    E.pre(cur, wr, fr, rs);
    const char* cA = (const char*)g.A + (size_t)cur.pm * tstepA; const char* cB = (const char*)g.Bt + (size_t)cur.pn * tstepB;
    PG8_STAGE(PG8_SB(0, 0), cB, voffB); PG8_STAGE(PG8_SB(0, 1), cB + hstepB, voffB); PG8_STAGE(PG8_SA(0, 0), cA, voffA); PG8_STAGE(PG8_SA(0, 1), cA + hstepA, voffA);
    if (wr == 1) PG8_BAR;
    PG8_WAIT_V(2); PG8_BAR;
    PG8_STAGE(PG8_SB(1, 0), cB + kstep, voffB); PG8_STAGE(PG8_SA(1, 0), cA + kstep, voffA); PG8_STAGE(PG8_SB(1, 1), cB + hstepB + kstep, voffB);
    PG8_WAIT_V(6); PG8_BAR;
    for (;;) {
        const bool has_next = S.next(ui + 1, nxt);
        const char* nA = has_next ? (const char*)g.A + (size_t)nxt.pm * tstepA : cA; const char* nB = has_next ? (const char*)g.Bt + (size_t)nxt.pn * tstepB : cB;
        for (int t = 0; t < nt; t += 2) {
            const bool last = (t == nt - 2);
            const char* a1 = cA + (size_t)(t + 1) * kstep;
            const char* a2 = last ? nA : cA + (size_t)(t + 2) * kstep; const char* b2 = last ? nB : cB + (size_t)(t + 2) * kstep;
            const char* a3 = a2 + kstep; const char* b3 = b2 + kstep;
            PG8_LDB(B0, 0, 0); PG8_LDB(B1, 0, 1); PG8_SCHED; PG8_LDA(At, 0, 0); PG8_STAGE(PG8_SA(1, 1), a1 + hstepA, voffA);
            PG8_WAIT_V(8); PG8_WAIT_L(0); PG8_BAR; PG8_MMA(0, 0, At, B0); PG8_MMA(0, 1, At, B1); PG8_BAR; PG8_SCHED;
            PG8_LDA(At, 0, 1); PG8_STAGE(PG8_SB(0, 0), b2, voffB); PG8_STAGE(PG8_SB(0, 1), b2 + hstepB, voffB); PG8_STAGE(PG8_SA(0, 0), a2, voffA);
            PG8_WAIT_V(8); PG8_WAIT_L(0); PG8_BAR; PG8_MMA(1, 0, At, B0); PG8_MMA(1, 1, At, B1); PG8_BAR; PG8_SCHED;
            PG8_LDB(B0, 1, 0); PG8_LDB(B1, 1, 1); PG8_SCHED; PG8_LDA(At, 1, 0); PG8_STAGE(PG8_SA(0, 1), a2 + hstepA, voffA);
            PG8_WAIT_V(8); PG8_WAIT_L(0); PG8_BAR; PG8_MMA(0, 0, At, B0); PG8_MMA(0, 1, At, B1); PG8_BAR; PG8_SCHED;
            PG8_LDA(At, 1, 1); PG8_STAGE(PG8_SB(1, 0), b3, voffB); PG8_STAGE(PG8_SB(1, 1), b3 + hstepB, voffB); PG8_STAGE(PG8_SA(1, 0), a3, voffA);
            PG8_WAIT_V(8); PG8_WAIT_L(0); PG8_BAR; PG8_MMA(1, 0, At, B0); PG8_MMA(1, 1, At, B1); PG8_BAR; PG8_SCHED;
        }
        if (wr == 0) PG8_BAR;
        E(acc, cur, wr, wc, fr, fq, wid, lane, rs);
        if (!has_next) break;
        E.pre(nxt, wr, fr, rs);
#pragma unroll
        for (int a = 0; a < 2; ++a)
#pragma unroll
            for (int b = 0; b < 2; ++b)
#pragma unroll
                for (int m = 0; m < 4; ++m)
#pragma unroll
                    for (int n = 0; n < 2; ++n) acc[a][b][m][n] = (f32x4){0.f, 0.f, 0.f, 0.f};
        cur = nxt; cA = nA; cB = nB; ++ui;
        if (wr == 1) PG8_BAR;
    }
    PG8_WAIT_V(0);
    PG8_BAR;
#undef PG8_SA
#undef PG8_SB
#undef PG8_STAGE
#undef PG8_LDA
#undef PG8_LDB
#undef PG8_MMA
#undef PG8_WAIT_V
#undef PG8_WAIT_L
#undef PG8_BAR
#undef PG8_SCHED
}
}
using pg8::Unit;
typedef const f32x4 (&AccRef)[2][2][4][2];

DI float row_rstd(const float* ssq, int r) { const f32x4 p = *(const f32x4*)(ssq + (size_t)r * 4); return __builtin_amdgcn_rsqf((p.x + p.y + p.z + p.w) * (1.0f / D) + EPS); }
DI u32x4 pack8f(const f32x4& a, const f32x4& b) { u32x4 w; w.x = cvtpk(a[0], a[1]); w.y = cvtpk(a[2], a[3]); w.z = cvtpk(b[0], b[1]); w.w = cvtpk(b[2], b[3]); return w; }

struct EpiSwiglu {
    static constexpr bool PERM = true;
    const float* ssq; bf16_t* act;
    DI void pre(const Unit& u, int wr, int fr, float (&rs)[8]) const {
#pragma unroll
        for (int ai = 0; ai < 2; ++ai)
#pragma unroll
            for (int m = 0; m < 4; ++m) rs[ai * 4 + m] = row_rstd(ssq, u.pm * 256 + ai * 128 + wr * 64 + m * 16 + fr);
    }
    DI void operator()(AccRef acc, const Unit& u, int wr, int wc, int fr, int fq, int, int, const float (&rsv)[8]) const {
#pragma unroll
        for (int ai = 0; ai < 2; ++ai)
#pragma unroll
            for (int m = 0; m < 4; ++m) {
                const int r = u.pm * 256 + ai * 128 + wr * 64 + m * 16 + fr; const float rs = rsv[ai * 4 + m];
                f32x4 v[2];
#pragma unroll
                for (int n = 0; n < 2; ++n) { const f32x4 a = acc[ai][0][m][n] * rs, b = acc[ai][1][m][n] * rs;
#pragma unroll
                    for (int j = 0; j < 4; ++j) v[n][j] = siluf_(a[j]) * b[j]; }
                *(u32x4*)(act + (size_t)r * DFF + u.pn * 128 + wc * 32 + 8 * fq) = pack8f(v[0], v[1]);
            }
    }
};
DI float fp8f(unsigned w, int i) { return i == 0 ? __builtin_amdgcn_cvt_f32_fp8((int)w, 0) : i == 1 ? __builtin_amdgcn_cvt_f32_fp8((int)w, 1) : i == 2 ? __builtin_amdgcn_cvt_f32_fp8((int)w, 2) : __builtin_amdgcn_cvt_f32_fp8((int)w, 3); }
DI float clamp8(float v) { return __builtin_fminf(__builtin_fmaxf(v, -448.f), 448.f); }
DI unsigned pk4fp8(float a, float b, float c, float d) { int p = 0; a = clamp8(a); b = clamp8(b); c = clamp8(c); d = clamp8(d); p = __builtin_amdgcn_cvt_pk_fp8_f32(a, b, p, false); p = __builtin_amdgcn_cvt_pk_fp8_f32(c, d, p, true); return (unsigned)p; }
struct EpiResid {
    static constexpr bool PERM = true;
    const float* x32in; float* x32out; bf16_t* xb; unsigned char* xlo; float* ssq; float alpha; LAS float* P;
    DI void pre(const Unit&, int, int, float (&)[8]) const {}
    static constexpr int RDEPTH = 4;
    DI void operator()(AccRef acc, const Unit& u, int wr, int wc, int fr, int fq, int wid, int lane, const float (&rsv)[8]) const {
        const int c0 = u.pn * 256 + wc * 32 + 8 * fq;
        const size_t base = (size_t)(u.pm * 256 + wr * 64 + fr) * D + c0;
        const bool first = x32in != nullptr, last = x32out != nullptr;
        u32x4 L[RDEPTH][4];
#define RES_OFF(p) (base + (size_t)(((p) >> 2) * 128 + ((p) & 3) * 16) * D)
#define RES_LOAD(p) do { const size_t o_ = RES_OFF(p); \
            if (first) { const float* q_ = x32in + o_; L[(p) % RDEPTH][0] = *(const u32x4*)(q_); L[(p) % RDEPTH][1] = *(const u32x4*)(q_ + 4); L[(p) % RDEPTH][2] = *(const u32x4*)(q_ + 128); L[(p) % RDEPTH][3] = *(const u32x4*)(q_ + 132); } \
            else { L[(p) % RDEPTH][0] = *(const u32x4*)(xb + o_); { const u32x2 t_ = *(const u32x2*)(xlo + o_); L[(p) % RDEPTH][1].x = t_.x; L[(p) % RDEPTH][1].y = t_.y; } \
                   L[(p) % RDEPTH][2] = *(const u32x4*)(xb + o_ + 128); { const u32x2 t_ = *(const u32x2*)(xlo + o_ + 128); L[(p) % RDEPTH][3].x = t_.x; L[(p) % RDEPTH][3].y = t_.y; } } } while (0)
#pragma unroll
        for (int p = 0; p < RDEPTH; ++p) RES_LOAD(p);
#pragma unroll
        for (int p = 0; p < 8; ++p) {
            const int ai = p >> 2, m = p & 3; const int rl = ai * 128 + wr * 64 + m * 16 + fr; const size_t off = RES_OFF(p); float ss = 0.f;
#pragma unroll
            for (int bj = 0; bj < 2; ++bj) { const size_t o = off + bj * 128;
                const u32x4 A0 = L[p % RDEPTH][2 * bj], A1 = L[p % RDEPTH][2 * bj + 1];
                f32x4 v0, v1; constexpr float IS = 1.0f / 512.0f;
                if (first) { v0 = __builtin_bit_cast(f32x4, A0); v1 = __builtin_bit_cast(f32x4, A1); }
                else { v0 = (f32x4){bflo(A0.x) + fp8f(A1.x, 0) * IS, bfhi(A0.x) + fp8f(A1.x, 1) * IS, bflo(A0.y) + fp8f(A1.x, 2) * IS, bfhi(A0.y) + fp8f(A1.x, 3) * IS};
                       v1 = (f32x4){bflo(A0.z) + fp8f(A1.y, 0) * IS, bfhi(A0.z) + fp8f(A1.y, 1) * IS, bflo(A0.w) + fp8f(A1.y, 2) * IS, bfhi(A0.w) + fp8f(A1.y, 3) * IS}; }
                v0 = v0 + acc[ai][bj][m][0] * alpha; v1 = v1 + acc[ai][bj][m][1] * alpha;
                if (last) { *(f32x4*)(x32out + o) = v0; *(f32x4*)(x32out + o + 4) = v1; }
                else { const u32x4 hw = pack8f(v0, v1); u32x2 lw;
                    lw.x = pk4fp8((v0[0] - bflo(hw.x)) * 512.f, (v0[1] - bfhi(hw.x)) * 512.f, (v0[2] - bflo(hw.y)) * 512.f, (v0[3] - bfhi(hw.y)) * 512.f);
                    lw.y = pk4fp8((v1[0] - bflo(hw.z)) * 512.f, (v1[1] - bfhi(hw.z)) * 512.f, (v1[2] - bflo(hw.w)) * 512.f, (v1[3] - bfhi(hw.w)) * 512.f);
                    *(u32x4*)(xb + o) = hw; *(u32x2*)(xlo + o) = lw; }
                ss += (v0[0] * v0[0] + v0[1] * v0[1]) + (v0[2] * v0[2] + v0[3] * v0[3]) + (v1[0] * v1[0] + v1[1] * v1[1]) + (v1[2] * v1[2] + v1[3] * v1[3]); }
            if (p + RDEPTH < 8) RES_LOAD(p + RDEPTH);
            ss += __shfl_xor(ss, 16); ss += __shfl_xor(ss, 32);
            if (fq == 0) P[rl * 4 + wc] = ss;
        }
#undef RES_LOAD
#undef RES_OFF
        asm volatile("s_waitcnt lgkmcnt(0)" ::: "memory"); __builtin_amdgcn_s_barrier(); asm volatile("" ::: "memory");
        if (lane < 32) { const int row = wid * 32 + lane; const f32x4 p = *(const LAS f32x4*)(P + row * 4); ssq[(size_t)(u.pm * 256 + row) * 4 + u.pn] = (p.x + p.y) + (p.z + p.w); }
    }
};
struct EpiRetQKV {
    static constexpr bool PERM = true;
    const float* ssq; const float* cs; const float* sn; bf16_t* Q; bf16_t* K; bf16_t* VO;
    DI void pre(const Unit& u, int wr, int fr, float (&rs)[8]) const {
#pragma unroll
        for (int ai = 0; ai < 2; ++ai)
#pragma unroll
            for (int m = 0; m < 4; ++m) rs[ai * 4 + m] = row_rstd(ssq, u.pm * 256 + ai * 128 + wr * 64 + m * 16 + fr);
    }
    DI void operator()(AccRef acc, const Unit& u, int wr, int wc, int fr, int fq, int, int, const float (&rsv)[8]) const {
        const int pn = u.pn;
        if (pn < 8) {
            constexpr int QDEPTH = 3;
            const int hd = pn & 3, i0 = wc * 32 + 8 * fq; const int r0 = u.pm * 256 + wr * 64 + fr;
            f32x4 CS[QDEPTH][4];
#define QKV_ROW(p) (r0 + ((p) >> 2) * 128 + ((p) & 3) * 16)
#define QKV_LOAD(p) do { const int t_ = QKV_ROW(p) & 2047; const float* c_ = cs + t_ * 128 + i0; const float* s_ = sn + t_ * 128 + i0; \
                CS[(p) % QDEPTH][0] = *(const f32x4*)c_; CS[(p) % QDEPTH][1] = *(const f32x4*)(c_ + 4); CS[(p) % QDEPTH][2] = *(const f32x4*)s_; CS[(p) % QDEPTH][3] = *(const f32x4*)(s_ + 4); } while (0)
#pragma unroll
            for (int p = 0; p < QDEPTH; ++p) QKV_LOAD(p);
#pragma unroll
            for (int p = 0; p < 8; ++p) { const int ai = p >> 2, m = p & 3; const int r = QKV_ROW(p); const float rs = rsv[p];
                const int b = r >> 11, t = r & 2047; const float sc = pn >= 4 ? rs * 0.0625f : rs;
                bf16_t* dst = (pn >= 4 ? K : Q) + ((size_t)(b * 4 + hd) * T + t) * 256 + i0;
                f32x4 o1[2], o2[2];
#pragma unroll
                for (int n = 0; n < 2; ++n) { const f32x4 c = CS[p % QDEPTH][n], sv = CS[p % QDEPTH][2 + n];
                    const f32x4 x1 = acc[ai][0][m][n] * sc, x2 = acc[ai][1][m][n] * sc; o1[n] = x1 * c - x2 * sv; o2[n] = x1 * sv + x2 * c; }
                *(u32x4*)dst = pack8f(o1[0], o1[1]); *(u32x4*)(dst + 128) = pack8f(o2[0], o2[1]);
                if (p + QDEPTH < 8) QKV_LOAD(p + QDEPTH); }
#undef QKV_LOAD
#undef QKV_ROW
        } else {
#pragma unroll
            for (int ai = 0; ai < 2; ++ai)
#pragma unroll
                for (int m = 0; m < 4; ++m) {
                    const int r = u.pm * 256 + ai * 128 + wr * 64 + m * 16 + fr; const float rs = rsv[ai * 4 + m];
                    bf16_t* dst = VO + (size_t)r * 2048 + (pn - 8) * 256 + wc * 32 + 8 * fq;
#pragma unroll
                    for (int bj = 0; bj < 2; ++bj) *(u32x4*)(dst + bj * 128) = pack8f(acc[ai][bj][m][0] * rs, acc[ai][bj][m][1] * rs);
                }
        }
    }
};

struct EpiRetG {
    static constexpr bool PERM = true;
    const float* ssq; const float* hssq; bf16_t* VO;
    DI void pre(const Unit& u, int wr, int fr, float (&rs)[8]) const {
#pragma unroll
        for (int ai = 0; ai < 2; ++ai)
#pragma unroll
            for (int m = 0; m < 4; ++m) rs[ai * 4 + m] = row_rstd(ssq, u.pm * 256 + ai * 128 + wr * 64 + m * 16 + fr);
    }
    DI void operator()(AccRef acc, const Unit& u, int wr, int wc, int fr, int fq, int, int, const float (&rsv)[8]) const {
        const int hd = u.pn >> 1;
        constexpr int GDEPTH = 4;
        const int r0 = u.pm * 256 + wr * 64 + fr; const int cc = u.pn * 256 + wc * 32 + 8 * fq;
        u32x4 L[GDEPTH][4];
#define G_ROW(p) (r0 + ((p) >> 2) * 128 + ((p) & 3) * 16)
#define G_LOAD(p) do { const int r_ = G_ROW(p); const bf16_t* d_ = VO + (size_t)r_ * 2048 + cc; const float* h_ = hssq + ((size_t)r_ * 4 + hd) * 8; \
            L[(p) % GDEPTH][0] = *(const u32x4*)d_; L[(p) % GDEPTH][1] = *(const u32x4*)(d_ + 128); L[(p) % GDEPTH][2] = *(const u32x4*)h_; L[(p) % GDEPTH][3] = *(const u32x4*)(h_ + 4); } while (0)
#pragma unroll
        for (int p = 0; p < GDEPTH; ++p) G_LOAD(p);
#pragma unroll
        for (int p = 0; p < 8; ++p) { const int ai = p >> 2, m = p & 3; const int r = G_ROW(p); const float rs = rsv[p];
            const f32x4 h0 = __builtin_bit_cast(f32x4, L[p % GDEPTH][2]), h1 = __builtin_bit_cast(f32x4, L[p % GDEPTH][3]);
            const float rh = __builtin_amdgcn_rsqf(((h0.x + h0.y) + (h0.z + h0.w) + (h1.x + h1.y) + (h1.z + h1.w)) * (1.0f / 512.f) + EPS);
            bf16_t* dst = VO + (size_t)r * 2048 + cc;
#pragma unroll
            for (int bj = 0; bj < 2; ++bj) { const u32x4 ov = L[p % GDEPTH][bj]; f32x4 a = acc[ai][bj][m][0] * rs, b = acc[ai][bj][m][1] * rs;
                a[0] = siluf_(a[0]) * bflo(ov.x) * rh; a[1] = siluf_(a[1]) * bfhi(ov.x) * rh; a[2] = siluf_(a[2]) * bflo(ov.y) * rh; a[3] = siluf_(a[3]) * bfhi(ov.y) * rh;
                b[0] = siluf_(b[0]) * bflo(ov.z) * rh; b[1] = siluf_(b[1]) * bfhi(ov.z) * rh; b[2] = siluf_(b[2]) * bflo(ov.w) * rh; b[3] = siluf_(b[3]) * bfhi(ov.w) * rh;
                *(u32x4*)(dst + bj * 128) = pack8f(a, b); }
            if (p + GDEPTH < 8) G_LOAD(p + GDEPTH); }
#undef G_LOAD
#undef G_ROW
    }
};

struct EpiNsaIn {
    static constexpr bool PERM = true;
    const float* ssq; const float* qgain; const float* kgain; bf16_t* QN; bf16_t* KV; float* GATE;
    DI void pre(const Unit& u, int wr, int fr, float (&rs)[8]) const {
#pragma unroll
        for (int ai = 0; ai < 2; ++ai)
#pragma unroll
            for (int m = 0; m < 4; ++m) rs[ai * 4 + m] = row_rstd(ssq, u.pm * 256 + ai * 128 + wr * 64 + m * 16 + fr);
    }
    DI void operator()(AccRef acc, const Unit& u, int wr, int wc, int fr, int fq, int, int, const float (&rsv)[8]) const {
        const int pn = u.pn;
        f32x4 gv[2][2];
        { const int sec0 = pn - 4; const float* gn0 = pn < 4 ? qgain : kgain + (sec0 == 2 ? 64 : 128);
#pragma unroll
          for (int bj = 0; bj < 2; ++bj)
#pragma unroll
              for (int n = 0; n < 2; ++n) gv[bj][n] = *(const f32x4*)(gn0 + bj * 32 + 8 * fq + 4 * n); }
#pragma unroll
        for (int ai = 0; ai < 2; ++ai)
#pragma unroll
            for (int m = 0; m < 4; ++m) {
                const int r = u.pm * 256 + ai * 128 + wr * 64 + m * 16 + fr; const float rs = rsv[ai * 4 + m];
                const int b = r >> 11, t = r & 2047;
                f32x4 v[2][2];
#pragma unroll
                for (int bj = 0; bj < 2; ++bj)
#pragma unroll
                    for (int n = 0; n < 2; ++n) v[bj][n] = acc[ai][bj][m][n] * rs;
                if (pn == 10) {
                    if (wc < 2) {
#pragma unroll
                        for (int n = 0; n < 2; ++n) { const int c = wc * 32 + 8 * fq + 4 * n; if (c < 48) { f32x4 o; for (int j = 0; j < 4; ++j) o[j] = sigmoidf_(v[0][n][j]); *(f32x4*)(GATE + (size_t)r * 48 + c) = o; } }
                    }
                } else {
                    const int sec = pn - 4;
                    const bool norm = (pn < 4) || sec == 2 || sec == 4;
                    const float* gn = pn < 4 ? qgain : kgain + (sec == 2 ? 64 : 128);
                    if (norm) {
                        float ss = 0.f;
#pragma unroll
                        for (int bj = 0; bj < 2; ++bj)
#pragma unroll
                            for (int n = 0; n < 2; ++n) ss += (v[bj][n][0] * v[bj][n][0] + v[bj][n][1] * v[bj][n][1]) + (v[bj][n][2] * v[bj][n][2] + v[bj][n][3] * v[bj][n][3]);
                        ss += __shfl_xor(ss, 16); ss += __shfl_xor(ss, 32);
                        float hn = __builtin_amdgcn_rsqf(ss * (1.0f / 64.f) + EPS); if (pn < 4) hn *= 0.125f * LOG2E;
#pragma unroll
                        for (int bj = 0; bj < 2; ++bj)
#pragma unroll
                            for (int n = 0; n < 2; ++n) v[bj][n] = v[bj][n] * hn * gv[bj][n];
                    }
                    bf16_t* dst = pn < 4 ? QN + ((size_t)(b * 16 + pn * 4 + wc) * T + t) * 64 : KV + (size_t)sec * KVSEC + ((size_t)(b * 4 + wc) * T + t) * 64;
#pragma unroll
                    for (int bj = 0; bj < 2; ++bj) *(u32x4*)(dst + bj * 32 + 8 * fq) = pack8f(v[bj][0], v[bj][1]);
                }
            }
    }
};
DI float gelu_tanh(float xx) { const float uu = 0.7978845608028654f * (xx + 0.044715f * xx * xx * xx); return xx * frcp(1.0f + fexp2(-2.0f * LOG2E * uu)); }
struct EpiCmp1 {
    static constexpr bool PERM = true;
    float* part;
    DI void pre(const Unit&, int, int, float (&)[8]) const {}
    DI void operator()(AccRef acc, const Unit& u, int wr, int wc, int fr, int fq, int, int, const float (&rsv)[8]) const {
#pragma unroll
        for (int ai = 0; ai < 2; ++ai)
#pragma unroll
            for (int m = 0; m < 4; ++m) {
                const int r = u.pm * 256 + ai * 128 + wr * 64 + m * 16 + fr;
#pragma unroll
                for (int bj = 0; bj < 2; ++bj) { float* d = part + (size_t)r * 256 + bj * 128 + wc * 32 + 8 * fq; *(f32x4*)d = acc[ai][bj][m][0]; *(f32x4*)(d + 4) = acc[ai][bj][m][1]; }
            }
    }
};

struct Params {
    const float* in[18]; float* out; unsigned char* ws; int ph_lo, ph_hi;
};
enum { I_X = 0, I_F1N, I_F1GU, I_F1D, I_MIXN, I_F2N, I_F2GU, I_F2D, I_RIN, I_ROUT, I_NIN, I_NOUT, I_QG, I_KG, I_CPOS, I_CW1, I_CW2, I_RELB };
#define GAS __attribute__((address_space(1)))
DI const float* pin(const Params& P, int k) { asm volatile("" : "+s"(k)); return (const float*)(GAS const float*)P.in[k]; }

DI int map_col(int mode, int n) {
    if (mode == 0) return n;
    if (mode == 1) { const int pn = n >> 8, bj = (n >> 7) & 1, c = n & 127; return bj * DFF + pn * 128 + c; }
    const int pn = n >> 8;
    if (pn < 10) { const int wc = (n >> 5) & 3, bj = (n >> 7) & 1, i = n & 31; return pn * 256 + wc * 64 + bj * 32 + i; }
    const int cc = n - 2560; return cc < 48 ? 2560 + cc : -1;
}
DI void transpose_item(const float* W, int K, int Nsrc, bf16_t* WT, int Ndst, int mode, const float* gain, LAS float* scr, int item, int lane) {
    const int nblk = Ndst / 64, kb = item / nblk, nb = item % nblk, k0 = 64 * kb, n0 = 64 * nb;
    const int col4 = (lane & 15) * 4, sc = map_col(mode, n0 + col4);
    f32x4 v[16];
#pragma unroll
    for (int i = 0; i < 16; ++i) { const int kk = 4 * i + (lane >> 4); v[i] = sc >= 0 ? *(const f32x4*)(W + (size_t)(k0 + kk) * Nsrc + sc) : (f32x4){0.f, 0.f, 0.f, 0.f}; }
#pragma unroll
    for (int i = 0; i < 16; ++i) { const int kk = 4 * i + (lane >> 4); const float gk = gain ? gain[k0 + kk] : 1.0f; LAS float* d = scr + kk * 65 + col4;
        d[0] = v[i][0] * gk; d[1] = v[i][1] * gk; d[2] = v[i][2] * gk; d[3] = v[i][3] * gk; }
    asm volatile("s_waitcnt lgkmcnt(0)" ::: "memory");
    const int c = lane & 7;
#pragma unroll
    for (int j = 0; j < 8; ++j) { const int n = (lane >> 3) + 8 * j; const LAS float* sp = scr + (8 * c) * 65 + n;
        u32x4 o; o.x = cvtpk(sp[0 * 65], sp[1 * 65]); o.y = cvtpk(sp[2 * 65], sp[3 * 65]); o.z = cvtpk(sp[4 * 65], sp[5 * 65]); o.w = cvtpk(sp[6 * 65], sp[7 * 65]);
        *(u32x4*)(WT + (size_t)(n0 + n) * K + k0 + 8 * c) = o; }
    asm volatile("s_waitcnt lgkmcnt(0)" ::: "memory");
}
DI void prologue(const Params& P, LAS unsigned char* lds, int tid, unsigned char* ws, int bid, int G) {
    const int lane = tid & 63, wid = tid >> 6; const int gw = bid * 8 + wid, NGW = G * 8;
    LAS float* scr = (LAS float*)(lds + wid * 16640);
    for (int jid = 0; jid < 28; ++jid) {
        const float* W; int K, Nsrc, Ndst, mode; bf16_t* WT; const float* gain = nullptr;
        if (jid < 16) { const int l = jid >> 2, sub = jid & 3, which = sub >> 1; unsigned char* base = ws + OFF_WFFN + (size_t)(l * 2 + which) * FFN_SZ;
            if ((sub & 1) == 0) { W = pin(P, which ? I_F2GU : I_F1GU) + (size_t)l * D * NGU; K = D; Nsrc = NGU; Ndst = NGU; mode = 1; WT = (bf16_t*)base; gain = pin(P, which ? I_F2N : I_F1N) + l * D; }
            else { W = pin(P, which ? I_F2D : I_F1D) + (size_t)l * DFF * D; K = DFF; Nsrc = D; Ndst = D; mode = 0; WT = (bf16_t*)(base + WGU_SZ); } }
        else if (jid < 20) { const int j = (jid - 16) >> 1, sub = (jid - 16) & 1; unsigned char* base = ws + OFF_WRET + (size_t)j * RET_SZ;
            if (sub == 0) { W = pin(P, I_RIN) + (size_t)j * D * 6144; K = D; Nsrc = 6144; Ndst = 6144; mode = 0; WT = (bf16_t*)base; gain = pin(P, I_MIXN) + (2 * j) * D; }
            else { W = pin(P, I_ROUT) + (size_t)j * 2048 * D; K = 2048; Nsrc = D; Ndst = D; mode = 0; WT = (bf16_t*)(base + RETIN_SZ); } }
        else { const int j = (jid - 20) >> 2, sub = (jid - 20) & 3; unsigned char* base = ws + OFF_WNSA + (size_t)j * NSA_SZ;
            if (sub == 0) { W = pin(P, I_NIN) + (size_t)j * D * 2608; K = D; Nsrc = 2608; Ndst = NSA_NPAD; mode = 2; WT = (bf16_t*)base; gain = pin(P, I_MIXN) + (2 * j + 1) * D; }
            else if (sub == 1) { W = pin(P, I_NOUT) + (size_t)j * D * D; K = D; Nsrc = D; Ndst = D; mode = 0; WT = (bf16_t*)(base + NSAIN_SZ); }
            else { const int jj = sub - 2; W = pin(P, I_CW1) + (size_t)(j * 2 + jj) * 2048 * 256; K = 2048; Nsrc = 256; Ndst = 256; mode = 0; WT = (bf16_t*)(base + NSAIN_SZ + NSAOUT_SZ + (size_t)jj * NSAW1_SZ); } }
        const int nitems = (K / 64) * (Ndst / 64);
        for (int it = gw; it < nitems; it += NGW) transpose_item(W, K, Nsrc, WT, Ndst, mode, gain, scr, it, lane);
    }
    { const float* x = pin(P, I_X); bf16_t* xb = (bf16_t*)(ws + OFF_XB); float* ssq = (float*)(ws + OFF_SSQ);
      for (int r = gw; r < M; r += NGW) { const f32x4* xr = (const f32x4*)(x + (size_t)r * D) + lane; u32x2* brow = (u32x2*)(xb + (size_t)r * D) + lane; float s = 0.f;
#pragma unroll
          for (int j = 0; j < 4; ++j) { const f32x4 v = xr[64 * j]; u32x2 w; w.x = cvtpk(v[0], v[1]); w.y = cvtpk(v[2], v[3]); brow[64 * j] = w; s += (v[0] * v[0] + v[1] * v[1]) + (v[2] * v[2] + v[3] * v[3]); }
          s = wave_sum(s); if (lane == 0) *(f32x4*)(ssq + (size_t)r * 4) = (f32x4){s, 0.f, 0.f, 0.f}; } }
    { float* cs = (float*)(ws + OFF_COS); float* sn = (float*)(ws + OFF_SIN);
      for (int idx = bid * NTHR + tid; idx < T * 128; idx += G * NTHR) { const int t = idx >> 7, i = idx & 127;
          const float invf = exp2f(-(float)i * (13.287712379549449f / 128.f));
          const double rev = (double)t * (double)invf * 0.15915494309189535; const double fr = rev - rint(rev); const float f = (float)fr;
          cs[idx] = __builtin_amdgcn_cosf(f); sn[idx] = __builtin_amdgcn_sinf(f); } }
    if (bid < 16) { const int lj = bid >> 2, n = (bid & 3) * 64 + lane; const float* pos = pin(P, I_CPOS) + (size_t)lj * 2048; const float* w1 = pin(P, I_CW1) + (size_t)lj * 2048 * 256;
        float s = 0.f;
#pragma unroll 8
        for (int k = wid * 256; k < wid * 256 + 256; ++k) s += pos[k] * w1[(size_t)k * 256 + n];
        __syncthreads();
        LAS float* red = (LAS float*)lds; red[wid * 64 + lane] = s; __syncthreads();
        if (wid == 0) { float a = 0.f; for (int w = 0; w < 8; ++w) a += red[w * 64 + lane]; ((float*)(ws + OFF_CB1))[lj * 256 + n] = a; }
        __syncthreads(); }
}

constexpr int R_KP = 544, R_VP = 144;
constexpr int R_KI = 0, R_VI = 128 * R_KP, R_VI2 = R_VI + 128 * R_VP, R_SI = R_VI2 + 128 * R_VP, R_HX = R_SI + 64 * R_KP, R_PX = R_HX + 1024, R_END = R_PX + 10 * 2048;
static_assert(R_END <= LDS_BYTES, "retention LDS");
template <int IBT, int VBT, bool DRY> DI void ret_unit(LAS unsigned char* lds, const bf16_t* Q, const bf16_t* K, bf16_t* VO, float* hssq, int b, int h, int vs, int tid) {
    const int lane = tid & 63, wid = __builtin_amdgcn_readfirstlane(tid >> 6), r32 = lane & 31, hi = lane >> 5;
    constexpr int ib = IBT, vb = VBT; const int db = wid;
    const float lg2 = log2f(1.0f - exp2f(-5.0f - (float)h));
    const float cdec = exp2f(128.f * lg2);
    const bf16_t* Qh = Q + (size_t)(b * 4 + h) * T * 256; const bf16_t* Kh = K + (size_t)(b * 4 + h) * T * 256;
    bf16_t* Vh = VO + (size_t)b * T * 2048 + h * 512 + vs * 64;
    LAS float* HX = (LAS float*)(lds + R_HX);
    f32x16 sacc[2];
#pragma unroll
    for (int i = 0; i < 16; ++i) { sacc[0][i] = 0.f; sacc[1][i] = 0.f; }
    bf16x8 qf[16];
#pragma unroll 1
    for (int c = 0; c < 16; ++c) {
        int t2 = tid; asm volatile("" : "+v"(t2));
        const int lane = t2 & 63, r32 = lane & 31, hi = lane >> 5, iq = IBT * 32 + r32;
        u32x4 kreg[8], vreg[2];
#pragma unroll
        for (int i = 0; i < 8; ++i) { const int p = t2 + 512 * i, row = p >> 5, c16 = p & 31; kreg[i] = *(const u32x4*)(Kh + (size_t)(c * 128 + row) * 256 + c16 * 8); }
#pragma unroll
        for (int i = 0; i < 2; ++i) { const int p = t2 + 512 * i, row = p >> 3, c16 = p & 7; vreg[i] = *(const u32x4*)(Vh + (size_t)(c * 128 + row) * 2048 + c16 * 8); }
        __syncthreads();
        if (!DRY && c > 0 && tid < 128) hssq[((size_t)(b * T + (c - 1) * 128 + tid) * 4 + h) * 8 + vs] = HX[tid * 2] + HX[tid * 2 + 1];
#pragma unroll
        for (int i = 0; i < 8; ++i) { const int p = tid + 512 * i, row = p >> 5, c16 = p & 31; *(LAS u32x4*)(lds + R_KI + row * R_KP + c16 * 16) = kreg[i]; }
#pragma unroll
        for (int i = 0; i < 2; ++i) { const int p = tid + 512 * i, row = p >> 3, c16 = p & 7; *(LAS u32x4*)(lds + R_VI + row * R_VP + c16 * 16) = vreg[i];
            const float kd = exp2f((float)(127 - row) * lg2); u32x4 w;
            w.x = cvtpk(bflo(vreg[i].x) * kd, bfhi(vreg[i].x) * kd); w.y = cvtpk(bflo(vreg[i].y) * kd, bfhi(vreg[i].y) * kd);
            w.z = cvtpk(bflo(vreg[i].z) * kd, bfhi(vreg[i].z) * kd); w.w = cvtpk(bflo(vreg[i].w) * kd, bfhi(vreg[i].w) * kd);
            *(LAS u32x4*)(lds + R_VI2 + row * R_VP + c16 * 16) = w; }
#pragma unroll
        for (int vbb = 0; vbb < 2; ++vbb)
#pragma unroll
            for (int rg = 0; rg < 4; ++rg) { u32x2 w; w.x = cvtpk(sacc[vbb][4 * rg], sacc[vbb][4 * rg + 1]); w.y = cvtpk(sacc[vbb][4 * rg + 2], sacc[vbb][4 * rg + 3]);
                *(LAS u32x2*)(lds + R_SI + (vbb * 32 + r32) * R_KP + (db * 32 + 8 * rg + 4 * hi) * 2) = w; }
        __syncthreads();
        f32x16 o;
#pragma unroll
        for (int i = 0; i < 16; ++i) o[i] = 0.f;
        const int iq2 = iq, hi2 = hi;
        const bf16_t* qp = Qh + (size_t)(c * 128 + iq2) * 256 + 8 * hi2;
        if (c == 0) {
#pragma unroll
            for (int s = 0; s < 16; ++s) qf[s] = *(const bf16x8*)(qp + 16 * s);
        }
        {
            constexpr int j0 = VBT ? 2 : 0;
            constexpr int nj = VBT ? (IBT >= 2 ? IBT - 1 : 0) : (IBT >= 1 ? 2 : 1);
            f32x16 a[2];
#pragma unroll
            for (int jj = 0; jj < 2; ++jj)
#pragma unroll
                for (int i = 0; i < 16; ++i) a[jj][i] = 0.f;
            bf16x8 F[2][3];
#define RET_LOADSTEP(FF, sx) do { const int so = (16 * (sx) + 8 * hi) * 2; \
                FF[0] = *(const LAS bf16x8*)(lds + R_SI + (vb * 32 + r32) * R_KP + so); \
                _Pragma("unroll") for (int jj = 0; jj < 2; ++jj) if (jj < nj) FF[1 + jj] = *(const LAS bf16x8*)(lds + R_KI + ((j0 + jj) * 32 + r32) * R_KP + so); } while (0)
#define RET_MMASTEP(FF, sx) do { o = MFMA32(FF[0], qf[sx], o); \
                _Pragma("unroll") for (int jj = 0; jj < 2; ++jj) if (jj < nj) a[jj] = MFMA32(FF[1 + jj], qf[sx], a[jj]); } while (0)
            RET_LOADSTEP(F[0], 0);
#pragma unroll
            for (int sx = 0; sx < 16; ++sx) { if (sx < 15) RET_LOADSTEP(F[(sx + 1) & 1], sx + 1); RET_MMASTEP(F[sx & 1], sx); __builtin_amdgcn_sched_barrier(0); }
#undef RET_LOADSTEP
#undef RET_MMASTEP
            { const float qdec = fexp2((float)(iq + 1) * lg2);
#pragma unroll
              for (int i = 0; i < 16; ++i) o[i] *= qdec; }
#pragma unroll
            for (int jj = 0; jj < 2; ++jj) if (jj < nj) { const int jb = j0 + jj;
#pragma unroll
                for (int r = 0; r < 16; ++r) { const int dl = iq2 - (jb * 32 + crow(r, hi2)); a[jj][r] = dl >= 0 ? a[jj][r] * fexp2((float)dl * lg2) : 0.f; }
#pragma unroll
                for (int s2 = 0; s2 < 2; ++s2) *(LAS bf16x8*)(lds + R_PX + ((IBT * (IBT + 1) / 2 + jb) * 2 + s2) * 1024 + lane * 16) = pack8(a[jj], s2); }
        }
        __syncthreads();
#pragma unroll
        for (int jb = 0; jb <= IBT; ++jb)
#pragma unroll
            for (int s2 = 0; s2 < 2; ++s2) { const bf16x8 pf = *(const LAS bf16x8*)(lds + R_PX + ((IBT * (IBT + 1) / 2 + jb) * 2 + s2) * 1024 + lane * 16);
                const bf16x8 vf = trfrag(lds + R_VI, R_VP, jb * 32 + 16 * s2, vb * 32, lane); o = MFMA32(vf, pf, o); if (s2) __builtin_amdgcn_sched_barrier(0); }
        { float ss = 0.f;
#pragma unroll
          for (int i = 0; i < 16; ++i) ss += o[i] * o[i];
          ss = pairsum(ss);
          if (hi == 0) HX[iq * 2 + vb] = ss;
          if (!DRY) {
          bf16_t* op = Vh + (size_t)(c * 128 + iq2) * 2048 + vb * 32;
#pragma unroll
          for (int j2 = 0; j2 < 2; ++j2) { u32x2 X, Y; X.x = cvtpk(o[8 * j2], o[8 * j2 + 1]); X.y = cvtpk(o[8 * j2 + 2], o[8 * j2 + 3]); Y.x = cvtpk(o[8 * j2 + 4], o[8 * j2 + 5]); Y.y = cvtpk(o[8 * j2 + 6], o[8 * j2 + 7]);
              *(u32x4*)(op + 8 * (2 * j2 + hi2)) = widen_pair(X, Y); } } }
        __builtin_amdgcn_sched_barrier(0);
        if (c < 15) {
#pragma unroll
            for (int s = 0; s < 16; ++s) qf[s] = *(const bf16x8*)(qp + 128 * 256 + 16 * s);
        }
#pragma unroll
        for (int i = 0; i < 16; ++i) { sacc[0][i] *= cdec; sacc[1][i] *= cdec; }
        { bf16x8 G[2][3];
          G[0][0] = trfrag(lds + R_KI, R_KP, 0, db * 32, lane); G[0][1] = trfrag(lds + R_VI2, R_VP, 0, 0, lane); G[0][2] = trfrag(lds + R_VI2, R_VP, 0, 32, lane);
#pragma unroll
          for (int s = 0; s < 8; ++s) {
              if (s < 7) { G[(s + 1) & 1][0] = trfrag(lds + R_KI, R_KP, 16 * (s + 1), db * 32, lane); G[(s + 1) & 1][1] = trfrag(lds + R_VI2, R_VP, 16 * (s + 1), 0, lane); G[(s + 1) & 1][2] = trfrag(lds + R_VI2, R_VP, 16 * (s + 1), 32, lane); }
              sacc[0] = MFMA32(G[s & 1][0], G[s & 1][1], sacc[0]); sacc[1] = MFMA32(G[s & 1][0], G[s & 1][2], sacc[1]); __builtin_amdgcn_sched_barrier(0); } }
    }
    __syncthreads();
    if (!DRY && tid < 128) hssq[((size_t)(b * T + 15 * 128 + tid) * 4 + h) * 8 + vs] = HX[tid * 2] + HX[tid * 2 + 1];
}

DI void cmp2_phase(const Params& P, int l, int tid, unsigned char* ws, unsigned char* ob, int bid, int G, LAS unsigned char* lds) {
    const int lane = tid & 63, wid = tid >> 6; const int half = G >> 1, j = bid >= half ? 1 : 0, lb = bid - j * half, nb = j ? G - half : half;
    const float* part = (const float*)(ob + OB_PART) + (size_t)j * 8192 * 256;
    const f32x4 bia = *(const f32x4*)((const float*)(ws + OFF_CB1) + (l * 2 + j) * 256 + lane * 4);
    const float* w2 = pin(P, I_CW2) + (size_t)(l * 2 + j) * 256 * 64;
    LAS float* W = (LAS float*)lds;
    __syncthreads();
#pragma unroll
    for (int i = 0; i < 8; ++i) { const int idx = (tid + 512 * i) * 4; *(LAS f32x4*)(W + idx) = *(const f32x4*)(w2 + idx); }
    __syncthreads();
    const float kg = pin(P, I_KG)[l * 192 + lane];
    for (int rr = lb * 8 + wid; rr < 8192; rr += nb * 8) {
        const int n = rr & 127;
        f32x4 hs = bia;
#pragma unroll
        for (int ks = 0; ks < 4; ++ks) hs = hs + *(const f32x4*)(part + ((size_t)ks * 2 * 8192 + rr) * 256 + lane * 4);
        const float h4[4] = {gelu_tanh(hs[0]), gelu_tanh(hs[1]), gelu_tanh(hs[2]), gelu_tanh(hs[3])};
        float acc0 = 0.f, acc1 = 0.f;
#pragma unroll 8
        for (int k4 = 0; k4 < 64; ++k4) {
            acc0 += __shfl(h4[0], k4) * W[(k4 * 4 + 0) * 64 + lane]; acc1 += __shfl(h4[1], k4) * W[(k4 * 4 + 1) * 64 + lane];
            acc0 += __shfl(h4[2], k4) * W[(k4 * 4 + 2) * 64 + lane]; acc1 += __shfl(h4[3], k4) * W[(k4 * 4 + 3) * 64 + lane]; }
        float acc = acc0 + acc1;
        if (j == 0) { const float ss = wave_sum(acc * acc) * (1.0f / 64.f); acc = acc * __builtin_amdgcn_rsqf(ss + EPS) * kg; }
        if (n == 127) acc = 0.f;
        bf16_t* dst = (bf16_t*)(ws + (j ? OFF_NVC : OFF_NKC)) + (size_t)rr * 64 + lane;
        *dst = (bf16_t)(cvtpk(acc, 0.f) & 0xffffu);
    }
}

constexpr int A_KP = 144;
constexpr int A_KT = 0, A_VT = 128 * A_KP, A_BIAS = 2 * 128 * A_KP, A_G4 = A_BIAS + 2304, A_EB = A_G4 + 8 * 32 * 33 * 4, A_IMP = A_EB + 8 * 32 * 33 * 4, A_SEL = A_IMP + 64 * 33 * 4, A_UNI = A_SEL + 256, A_END = A_UNI + 16;
static_assert(A_END <= LDS_BYTES, "attention LDS");

DI float max3f(float a, float b, float c) { return __builtin_fmaxf(__builtin_fmaxf(a, b), c); }
DI void attn_tile(LAS const unsigned char* KT, LAS const unsigned char* VT, const bf16x8 (&qf)[4], int kbase, int qpos, bool selbit, LAS const float* brow, float cb, int kind, float& mrun, float& lrun, f32x16 (&o)[2], int lane) {
    const int r32 = lane & 31, hi = lane >> 5;
    f32x16 s0, s1;
    { const f32x16 z = {0.f, 0.f, 0.f, 0.f, 0.f, 0.f, 0.f, 0.f, 0.f, 0.f, 0.f, 0.f, 0.f, 0.f, 0.f, 0.f};
      const bf16x8 a0 = *(const LAS bf16x8*)(KT + r32 * A_KP + (8 * hi) * 2), a1 = *(const LAS bf16x8*)(KT + (32 + r32) * A_KP + (8 * hi) * 2);
      s0 = MFMA32(a0, qf[0], z); s1 = MFMA32(a1, qf[0], z); }
#pragma unroll
    for (int s = 1; s < 4; ++s) { const bf16x8 a0 = *(const LAS bf16x8*)(KT + r32 * A_KP + (16 * s + 8 * hi) * 2), a1 = *(const LAS bf16x8*)(KT + (32 + r32) * A_KP + (16 * s + 8 * hi) * 2);
        s0 = MFMA32(a0, qf[s], s0); s1 = MFMA32(a1, qf[s], s1); }
    if (kind & 1) {
        const int dbase = qpos - kbase - 4 * hi;
        if (kind & 2) {
#pragma unroll
            for (int r = 0; r < 16; ++r) { const int d0 = dbase - ((r & 3) + 8 * (r >> 2)), d1 = d0 - 32;
                const float b0 = brow[min((unsigned)d0, 128u)], b1 = brow[min((unsigned)d1, 128u)];
                s0[r] = d0 >= 0 ? s0[r] + b0 : -1e30f; s1[r] = d1 >= 0 ? s1[r] + b1 : -1e30f; }
        } else {
#pragma unroll
            for (int r = 0; r < 16; ++r) { const int d0 = dbase - ((r & 3) + 8 * (r >> 2)), d1 = d0 - 32;
                s0[r] += brow[min((unsigned)d0, 128u)]; s1[r] += brow[min((unsigned)d1, 128u)]; }
        }
    } else if (kind & 2) {
        const int dbase = qpos - kbase - 4 * hi;
#pragma unroll
        for (int r = 0; r < 16; ++r) { const int d0 = dbase - ((r & 3) + 8 * (r >> 2)), d1 = d0 - 32; s0[r] = d0 < 512 ? s0[r] : -1e30f; s1[r] = d1 < 512 ? s1[r] : -1e30f; }
    }
    const float cadd = (kind & 1) ? 0.f : cb;
    float mx = fmaxf(s0[0], s1[0]);
#pragma unroll
    for (int r = 1; r < 16; ++r) mx = max3f(mx, s0[r], s1[r]);
    mx = selbit ? mx + cadd : -1e30f;
    mx = pairmax(mx);
    if (__any(mx > mrun + 8.0f)) { const float mnew = fmaxf(mrun, mx), alpha = fexp2(mrun - mnew); mrun = mnew; lrun *= alpha;
#pragma unroll
        for (int i = 0; i < 16; ++i) { o[0][i] *= alpha; o[1][i] *= alpha; } }
    const float t = selbit ? cadd - mrun : -1e30f;
    float rs = 0.f;
#pragma unroll
    for (int r = 0; r < 16; ++r) { s0[r] = fexp2(s0[r] + t); s1[r] = fexp2(s1[r] + t); rs += s0[r] + s1[r]; }
    lrun += rs;
    const bf16x8 p00 = pack8(s0, 0), p01 = pack8(s0, 1), p10 = pack8(s1, 0), p11 = pack8(s1, 1);
#pragma unroll
    for (int db = 0; db < 2; ++db) {
        o[db] = MFMA32(trfrag(VT, A_KP, 0, db * 32, lane), p00, o[db]);
        o[db] = MFMA32(trfrag(VT, A_KP, 16, db * 32, lane), p01, o[db]);
        o[db] = MFMA32(trfrag(VT, A_KP, 32, db * 32, lane), p10, o[db]);
        o[db] = MFMA32(trfrag(VT, A_KP, 48, db * 32, lane), p11, o[db]);
    }
}

template <int MODE>
DI void attn_branch(LAS unsigned char* lds, const bf16_t* Kg, const bf16_t* Vg, const bf16x8 (&qf)[4], int qpos, int qt, unsigned selmask, unsigned tiles, LAS const float* brow, float gate, LAS float* park, int tid, const u32x4 pk0, const u32x4 pv0) {
    asm volatile("" : "+v"(tid));
    const int lane = tid & 63;
    const float cb = brow[128];
    float mrun = -1e30f, lrun = 0.f; f32x16 o[2];
#pragma unroll
    for (int i = 0; i < 16; ++i) { o[0][i] = 0.f; o[1][i] = 0.f; }
    const int prow = tid >> 3, pc = tid & 7;
    unsigned rem = tiles; int buf = 0;
    int j = MODE == 0 ? __builtin_ctz(rem) : 31 - __builtin_clz(rem); rem &= ~(1u << j);
    { *(LAS u32x4*)(lds + A_KT + prow * A_KP + pc * 16) = pk0; *(LAS u32x4*)(lds + A_VT + prow * A_KP + pc * 16) = pv0; }
    __syncthreads();
    for (;;) {
        const bool more = rem != 0u; int jn = 0; u32x4 kk, vv;
        if (more) { jn = MODE == 0 ? __builtin_ctz(rem) : 31 - __builtin_clz(rem); rem &= ~(1u << jn); kk = *(const u32x4*)(Kg + (size_t)(jn * 64 + prow) * 64 + pc * 8); vv = *(const u32x4*)(Vg + (size_t)(jn * 64 + prow) * 64 + pc * 8); }
        const int kind = (j >= qt - 2 ? 1 : 0) | ((j == qt || (MODE == 1 && j == qt - 8)) ? 2 : 0);
        attn_tile(lds + A_KT + buf * 64 * A_KP, lds + A_VT + buf * 64 * A_KP, qf, j * 64, qpos, MODE == 1 ? true : (((selmask >> j) & 1u) != 0u), brow, cb, kind, mrun, lrun, o, lane);
        if (more) { const int nb = buf ^ 1; *(LAS u32x4*)(lds + A_KT + nb * 64 * A_KP + prow * A_KP + pc * 16) = kk; *(LAS u32x4*)(lds + A_VT + nb * 64 * A_KP + prow * A_KP + pc * 16) = vv; }
        __syncthreads();
        if (!more) break;
        j = jn; buf ^= 1;
    }
    const float lt = pairsum(lrun); const float sc = lt > 0.f ? gate * frcp(lt) : 0.f;
#pragma unroll
    for (int i = 0; i < 16; ++i) { park[i * 64] += o[0][i] * sc; park[(16 + i) * 64] += o[1][i] * sc; }
}

DI void nsa_unit(LAS unsigned char* lds, const Params& P, unsigned char* ws, int b, int g, int qt, int tid, bool build_bias) {
    { GAS unsigned char* wsg = (GAS unsigned char*)ws; asm volatile("" : "+s"(wsg)); ws = (unsigned char*)wsg; } asm volatile("" : "+v"(tid));
    const int lane = tid & 63, wid = __builtin_amdgcn_readfirstlane(tid >> 6), r32 = lane & 31, hi = lane >> 5;
    const int p = wid & 3, qs = wid >> 2, head = g * 4 + p, qpos = qt * 64 + qs * 32 + r32;
    const bf16_t* QN = (const bf16_t*)(ws + OFF_NQ); const bf16_t* KV = (const bf16_t*)(ws + OFF_NKV); const float* GATE = (const float*)(ws + OFF_NGATE);
    LAS float* BIAS = (LAS float*)(lds + A_BIAS); LAS float* G4 = (LAS float*)(lds + A_G4); LAS float* EB = (LAS float*)(lds + A_EB); LAS float* IMP = (LAS float*)(lds + A_IMP);
    LAS unsigned* SEL = (LAS unsigned*)(lds + A_SEL); LAS unsigned* UNI = (LAS unsigned*)(lds + A_UNI);
    __syncthreads();
    if (build_bias) for (int idx = tid; idx < 4 * 129; idx += NTHR) { const int pp = idx / 129, dist = idx - pp * 129; int bk;
        if (dist < 16) bk = dist; else { const float nf = (float)dist; int lg = 16 + (int)(logf(nf / 16.f) / 2.0794415416798357f * 16.f); bk = lg < 31 ? lg : 31; }
        BIAS[pp * 132 + dist] = pin(P, I_RELB)[bk * 16 + g * 4 + pp] * LOG2E; }
    if (tid == 0) UNI[0] = 0u;
    bf16x8 qf[4];
    { const bf16_t* qp = QN + ((size_t)(b * 16 + head) * T + qpos) * 64 + 8 * hi;
#pragma unroll
      for (int s = 0; s < 4; ++s) qf[s] = *(const bf16x8*)(qp + 16 * s); }
    const float* gp = GATE + (size_t)(b * T + qpos) * 48 + head; const float g0 = gp[0], g1 = gp[16], g2 = gp[32];
    const size_t tpo = (size_t)(tid >> 3) * 64 + (tid & 7) * 8;
    const bf16_t* KVb = KV + (size_t)(b * 4 + g) * T * 64;
    const u32x4 sk0 = *(const u32x4*)(KVb + 2 * KVSEC + tpo), sv0 = *(const u32x4*)(KVb + 3 * KVSEC + tpo);
    LAS const float* brow = BIAS + p * 132;
    LAS float* park = (LAS float*)(lds + A_G4) + wid * 2048 + lane;
    { const bf16_t* kc = (const bf16_t*)(ws + OFF_NKC) + (size_t)(b * 4 + g) * 128 * 64; const bf16_t* vc = (const bf16_t*)(ws + OFF_NVC) + (size_t)(b * 4 + g) * 128 * 64;
#pragma unroll
      for (int i = 0; i < 2; ++i) { const int pidx = tid + 512 * i, row = pidx >> 3, pc = pidx & 7;
          *(LAS u32x4*)(lds + A_KT + row * A_KP + pc * 16) = *(const u32x4*)(kc + row * 64 + pc * 8); *(LAS u32x4*)(lds + A_VT + row * A_KP + pc * 16) = *(const u32x4*)(vc + row * 64 + pc * 8); } }
    __syncthreads();
    f32x16 oc0, oc1;
    {
        f32x16 sc[4]; float mx = -1e30f;
#pragma unroll
        for (int t = 0; t < 4; ++t) {
#pragma unroll
            for (int i = 0; i < 16; ++i) sc[t][i] = 0.f;
#pragma unroll
            for (int s = 0; s < 4; ++s) { const bf16x8 a = *(const LAS bf16x8*)(lds + A_KT + (32 * t + r32) * A_KP + (16 * s + 8 * hi) * 2); sc[t] = MFMA32(a, qf[s], sc[t]); }
#pragma unroll
            for (int r = 0; r < 16; ++r) { const int n = 32 * t + crow(r, hi), dist = qpos - (16 * n + 31); const bool v = dist >= 0 && n < 127;
                sc[t][r] = v ? sc[t][r] + brow[min((unsigned)dist, 128u)] : -1e30f; mx = fmaxf(mx, sc[t][r]); }
        }
        mx = pairmax(mx);
        float rs = 0.f;
#pragma unroll
        for (int t = 0; t < 4; ++t)
#pragma unroll
            for (int r = 0; r < 16; ++r) { sc[t][r] = sc[t][r] > -1e29f ? fexp2(sc[t][r] - mx) : 0.f; rs += sc[t][r]; }
        rs = pairsum(rs);
        const float inv = rs > 0.f ? frcp(rs) : 0.f;
#pragma unroll
        for (int t = 0; t < 4; ++t)
#pragma unroll
            for (int r = 0; r < 16; ++r) sc[t][r] *= inv;
#pragma unroll
        for (int t = 0; t < 4; ++t)
#pragma unroll
            for (int rg = 0; rg < 4; ++rg) { const int jj = 8 * t + 2 * rg + hi; G4[(wid * 32 + r32) * 33 + jj] = (sc[t][4 * rg] + sc[t][4 * rg + 1]) + (sc[t][4 * rg + 2] + sc[t][4 * rg + 3]); EB[(wid * 32 + r32) * 33 + jj] = sc[t][4 * rg + 3]; }
        f32x16 o[2];
#pragma unroll
        for (int i = 0; i < 16; ++i) { o[0][i] = 0.f; o[1][i] = 0.f; }
#pragma unroll
        for (int t = 0; t < 4; ++t)
#pragma unroll
            for (int s2 = 0; s2 < 2; ++s2) { const bf16x8 pf = pack8(sc[t], s2);
                o[0] = MFMA32(trfrag(lds + A_VT, A_KP, 32 * t + 16 * s2, 0, lane), pf, o[0]); o[1] = MFMA32(trfrag(lds + A_VT, A_KP, 32 * t + 16 * s2, 32, lane), pf, o[1]); }
#pragma unroll
        for (int i = 0; i < 16; ++i) { o[0][i] *= g0; o[1][i] *= g0; }
        oc0 = o[0]; oc1 = o[1];
    }
    __syncthreads();
#pragma unroll
    for (int i = 0; i < 4; ++i) { const int idx = tid + 512 * i, q = idx >> 5, jj = idx & 31, w0 = (q >> 5) * 4, ql = q & 31; float s = 0.f;
#pragma unroll
        for (int pp = 0; pp < 4; ++pp) { s += G4[((w0 + pp) * 32 + ql) * 33 + jj]; if (jj > 0) s += EB[((w0 + pp) * 32 + ql) * 33 + jj - 1]; }
        IMP[q * 33 + jj] = s; }
    __syncthreads();
    { const int cur = qt, q = tid >> 3, sub = tid & 7; unsigned mask;
        if (cur < 8) mask = (2u << cur) - 1u;
        else { mask = 1u | (1u << cur) | (1u << (cur - 1));
            float iv[4];
#pragma unroll
            for (int e = 0; e < 4; ++e) iv[e] = IMP[q * 33 + sub * 4 + e];
#pragma unroll 1
            for (int it = 0; it < 5; ++it) { float bv = -3.0e38f; int best = 99;
#pragma unroll
                for (int e = 0; e < 4; ++e) { const int jj = sub * 4 + e; const bool ok = jj >= 1 && jj <= cur - 2 && !((mask >> jj) & 1u) && iv[e] > bv; bv = ok ? iv[e] : bv; best = ok ? jj : best; }
#pragma unroll
                for (int x = 1; x < 8; x <<= 1) { const float ov = __shfl_xor(bv, x); const int oi = __shfl_xor(best, x); const bool tk = ov > bv || (ov == bv && oi < best); bv = tk ? ov : bv; best = tk ? oi : best; }
                mask |= 1u << best; } }
        if (sub == 0) { SEL[q] = mask; atomicOr((unsigned*)UNI, mask); } }
    __syncthreads();
    const unsigned selmask = SEL[qs * 32 + r32], uni = UNI[0];
#pragma unroll
    for (int i = 0; i < 16; ++i) { park[i * 64] = oc0[i]; park[(16 + i) * 64] = oc1[i]; }
    u32x4 wk0, wv0;
    { GAS unsigned char* wsg = (GAS unsigned char*)ws; asm volatile("" : "+s"(wsg)); const bf16_t* KVs = (const bf16_t*)((unsigned char*)wsg + OFF_NKV) + (size_t)(b * 4 + g) * T * 64;
      wk0 = *(const u32x4*)(KVs + 4 * KVSEC + (size_t)qt * 4096 + tpo); wv0 = *(const u32x4*)(KVs + 5 * KVSEC + (size_t)qt * 4096 + tpo);
      attn_branch<0>(lds, KVs + 2 * KVSEC, KVs + 3 * KVSEC, qf, qpos, qt, selmask, uni, brow, g1, park, tid, sk0, sv0); }
    { GAS unsigned char* wsg = (GAS unsigned char*)ws; asm volatile("" : "+s"(wsg)); const bf16_t* KVs = (const bf16_t*)((unsigned char*)wsg + OFF_NKV) + (size_t)(b * 4 + g) * T * 64;
      const int lo = qt >= 8 ? qt - 8 : 0; const unsigned wt = ((2u << qt) - 1u) & ~((1u << lo) - 1u);
      attn_branch<1>(lds, KVs + 4 * KVSEC, KVs + 5 * KVSEC, qf, qpos, qt, 0u, wt, brow, g2, park, tid, wk0, wv0); }
    { GAS unsigned char* wsg = (GAS unsigned char*)ws; asm volatile("" : "+s"(wsg)); ws = (unsigned char*)wsg; }
    bf16_t* op = (bf16_t*)((unsigned char*)(GAS unsigned char*)P.out + OB_NO) + (size_t)(b * T + qpos) * D + head * 64;
#pragma unroll
    for (int db = 0; db < 2; ++db)
#pragma unroll
        for (int j2 = 0; j2 < 2; ++j2) { const LAS float* pk = park + (db * 16 + 8 * j2) * 64; u32x2 X, Y;
            X.x = cvtpk(pk[0], pk[64]); X.y = cvtpk(pk[128], pk[192]); Y.x = cvtpk(pk[256], pk[320]); Y.y = cvtpk(pk[384], pk[448]);
            *(u32x4*)(op + db * 32 + 8 * (2 * j2 + hi)) = widen_pair(X, Y); }
}


constexpr size_t OFF_CTL = 7 * MiB + 512 * 1024;
constexpr int CTL_BYTES = 16384;
constexpr int LDS_BARST = LDS_BYTES - 64;
#define XB_TMO      128
#define XB_XCNT(j)  (256  + 64 * (j))
#define XB_XSUB(j)  (1280 + 64 * (j))
#define XB_XGEN(j)  (2304 + 64 * (j))
#define XB_TOP      3328
#define XB_TOPGEN   3392
#define XB_SPIN_CAP (1u << 22)
DI unsigned xb_ld(unsigned* p)              { return __hip_atomic_load(p, __ATOMIC_RELAXED, __HIP_MEMORY_SCOPE_AGENT); }
DI unsigned xb_add(unsigned* p, unsigned v) { return __hip_atomic_fetch_add(p, v, __ATOMIC_RELAXED, __HIP_MEMORY_SCOPE_AGENT); }
DI unsigned xb_xcc_id() { return (unsigned)__builtin_amdgcn_s_getreg((3 << 11) | 20) & 0xFu; }
#define XB_SPIN(cond, bar) do { unsigned _sp = 0; while (cond) { __builtin_amdgcn_s_sleep(1); \
    if ((++_sp & 255u) == 0u) { if (xb_ld(&(bar)[XB_TMO])) break; if (_sp > XB_SPIN_CAP) { atomicAdd(&(bar)[XB_TMO], 1u); break; } } } } while (0)
struct XcdBarrier { unsigned* bar; unsigned x; volatile LAS unsigned* st; };
DI XcdBarrier xcd_barrier_post(unsigned* bar, volatile LAS unsigned* st) {
    XcdBarrier b; b.bar = bar; b.x = xb_xcc_id(); b.st = st;
    if (threadIdx.x == 0) (void)xb_add(&bar[XB_XCNT(b.x)], 1u);
    return b;
}
DI void xcd_barrier_complete(unsigned* bar, unsigned x, unsigned& nloc, unsigned& nx) {
    const unsigned G = gridDim.x * gridDim.y * gridDim.z;
    unsigned sum, cnt, mine, sp = 0u;
    for (;;) {
        sum = 0u; cnt = 0u; mine = 0u;
#pragma unroll
        for (unsigned j = 0; j < 16; ++j) { const unsigned c = xb_ld(&bar[XB_XCNT(j)]); sum += c; cnt += (c > 0u) ? 1u : 0u; mine = (j == x) ? c : mine; }
        if (sum == G) break;
        __builtin_amdgcn_s_sleep(1);
        if ((++sp & 255u) == 0u) { if (xb_ld(&bar[XB_TMO])) break; if (sp > XB_SPIN_CAP) { atomicAdd(&bar[XB_TMO], 1u); break; } }
    }
    nloc = mine > 0u ? mine : 1u; nx = cnt > 0u ? cnt : 1u;
}
DI void xcd_barrier(const XcdBarrier& b) {
    asm volatile("s_waitcnt vmcnt(0)" ::: "memory");
    __syncthreads();
    if (threadIdx.x == 0) {
        unsigned* bar = b.bar;
        __builtin_amdgcn_s_waitcnt(0);
        unsigned nloc = b.st[0], nx = b.st[1];
        if (nloc == 0u) { xcd_barrier_complete(bar, b.x, nloc, nx); b.st[0] = nloc; b.st[1] = nx; }
        const unsigned old = xb_add(&bar[XB_XSUB(b.x)], 1u);
        const unsigned gen = old / nloc;
        if (old + 1u == (gen + 1u) * nloc) {
            __builtin_amdgcn_fence(__ATOMIC_RELEASE, "agent");
            asm volatile("s_waitcnt vmcnt(0)" ::: "memory");
            const unsigned og = xb_add(&bar[XB_TOP], 1u);
            const unsigned tg = og / nx;
            if (og + 1u == (tg + 1u) * nx) xb_add(&bar[XB_TOPGEN], 1u);
            else XB_SPIN(xb_ld(&bar[XB_TOPGEN]) == tg, bar);
            __builtin_amdgcn_fence(__ATOMIC_ACQUIRE, "agent");
            xb_add(&bar[XB_XGEN(b.x)], 1u);
            asm volatile("s_waitcnt vmcnt(0)" ::: "memory");
        } else {
            XB_SPIN(xb_ld(&bar[XB_XGEN(b.x)]) == gen, bar);
            __builtin_amdgcn_fence(__ATOMIC_ACQUIRE, "agent");
            asm volatile("s_waitcnt vmcnt(0)" ::: "memory");
        }
    }
    __syncthreads();
}

#ifndef EN_MASK
#define EN_MASK 0xffff
#endif
#define EN(b) ((EN_MASK >> (b)) & 1)
#ifndef PROBE_ATTN
#define PROBE_ATTN 0
#endif
#ifndef PROBE_RET
#define PROBE_RET 0
#endif
#ifndef PROBE_GU
#define PROBE_GU 0
#endif
#ifndef PROBE_SYNC
#define PROBE_SYNC 0
#endif
#ifndef PROBE_PRO
#define PROBE_PRO 0
#endif
constexpr int NPHASE = 35;
__global__ void __launch_bounds__(NTHR, 2) fwd_kernel(Params P) {
    extern __shared__ __attribute__((aligned(16))) unsigned char lds_raw[];
    LAS unsigned char* lds = (LAS unsigned char*)lds_raw;
    if (threadIdx.x < 16) ((LAS unsigned*)(lds + LDS_BARST))[threadIdx.x] = 0u;
    __syncthreads();
    (void)xcd_barrier_post((unsigned*)(P.ws + OFF_CTL), (volatile LAS unsigned*)(lds + LDS_BARST));
    const int wv0 = __builtin_amdgcn_readfirstlane(threadIdx.x >> 6);
    for (int ph = P.ph_lo; ph < P.ph_hi; ++ph) {
        unsigned allm = ~0u; asm volatile("" : "+s"(allm));
        int tid = wv0 * 64 + (int)__builtin_amdgcn_mbcnt_hi(allm, __builtin_amdgcn_mbcnt_lo(allm, 0u)); asm volatile("" : "+v"(tid));
        GAS unsigned char* wsg = (GAS unsigned char*)P.ws; asm volatile("" : "+s"(wsg)); unsigned char* ws = (unsigned char*)wsg;
        int bid = blockIdx.x, G = gridDim.x; asm volatile("" : "+s"(bid), "+s"(G));
        GAS unsigned char* obg = (GAS unsigned char*)P.out; asm volatile("" : "+s"(obg)); unsigned char* ob = (unsigned char*)obg;
        float* ssq = (float*)(ws + OFF_SSQ); bf16_t* xb = (bf16_t*)(ws + OFF_XB);
        int layer = -1, kind = -1;
        if (ph > 0) { int q = ph - 1; for (int l = 0; l < DEPTH; ++l) { const int np = (l & 1) ? 9 : 8; if (q < np) { layer = l; kind = q; break; } q -= np; } }
        const bool is_nsa = layer & 1; const int j = layer >> 1;
        const int nmix = is_nsa ? 5 : 4;
        int gk = -1;
        int which = 0;
        if (ph == 0) gk = -2;
        else if (kind == 0) { gk = 0; which = 0; } else if (kind == 1) { gk = 1; which = 0; }
        else if (kind == 2 + nmix) { gk = 0; which = 1; } else if (kind == 3 + nmix) { gk = 1; which = 1; }
        else if (kind == 1 + nmix) gk = 2;
        else gk = 10 + (kind - 2);
        if (gk == -2) { if (EN(0)) prologue(P, lds, tid, ws, bid, G); }
        else if (gk == 0) {
            pg8::Gemm g{xb, (const bf16_t*)(ws + OFF_WFFN + (size_t)(layer * 2 + which) * FFN_SZ), M, NGU, D, D}; pg8::StaticOrder S; S.init(M, NGU, G, bid);
            EpiSwiglu E{ssq, (bf16_t*)(ws + OFF_ACT)}; if (EN(1)) pg8::gemm_phase(lds, g, S, E, tid);
        } else if (gk == 1 || gk == 2) {
            const bf16_t* A; const bf16_t* Bt; int K; float alpha;
            if (gk == 1) { A = (const bf16_t*)(ws + OFF_ACT); Bt = (const bf16_t*)(ws + OFF_WFFN + (size_t)(layer * 2 + which) * FFN_SZ + WGU_SZ); K = DFF; alpha = 0.5f; }
            else if (!is_nsa) { A = (const bf16_t*)(ws + OFF_RVO); Bt = (const bf16_t*)(ws + OFF_WRET + (size_t)j * RET_SZ + RETIN_SZ); K = 2048; alpha = 1.f; }
            else { A = (const bf16_t*)(ob + OB_NO); Bt = (const bf16_t*)(ws + OFF_WNSA + (size_t)j * NSA_SZ + NSAIN_SZ); K = D; alpha = 1.f; }
            pg8::Gemm g{A, Bt, M, D, K, K}; pg8::StaticOrder S; S.init(M, D, G, bid);
            EpiResid E{(layer == 0 && gk == 1 && which == 0) ? pin(P, I_X) : (const float*)nullptr, (layer == DEPTH - 1 && gk == 1 && which == 1) ? (float*)ob : (float*)nullptr, xb, (unsigned char*)(ws + OFF_XLO), ssq, alpha, (LAS float*)(lds + EPI_LDS)}; if (EN(2)) pg8::gemm_phase(lds, g, S, E, tid);
        } else if (!is_nsa) {
            const bf16_t* Win = (const bf16_t*)(ws + OFF_WRET + (size_t)j * RET_SZ);
            if (gk == 10) { pg8::Gemm g{xb, Win, M, 4096, D, D}; pg8::StaticOrder S; S.init(M, 4096, G, bid);
                EpiRetQKV E{ssq, (const float*)(ws + OFF_COS), (const float*)(ws + OFF_SIN), (bf16_t*)(ob + OB_RQ), (bf16_t*)(ob + OB_RK), (bf16_t*)(ws + OFF_RVO)}; if (EN(3)) pg8::gemm_phase(lds, g, S, E, tid); }
            else if (gk == 11) { const int wv = __builtin_amdgcn_readfirstlane(tid >> 6), ibw = wv < 4 ? wv : 7 - wv;
#define RET_ARGS lds, (const bf16_t*)(ob + OB_RQ), (const bf16_t*)(ob + OB_RK), (bf16_t*)(ws + OFF_RVO), (float*)(ws + OFF_HSSQ), u >> 5, (u >> 3) & 3, u & 7, tid
                if (EN(4)) for (int uu = bid; uu < 512; uu += G) {
                    int u = uu; if (G == 256) { const int kk = uu >> 8, bb = uu & 255; u = ((kk * 32 + (bb & 7) * 4 + (bb >> 6)) << 3) | ((bb >> 3) & 7); }
                    if (wv < 4) { if (ibw == 0) ret_unit<0, 0, false>(RET_ARGS); else if (ibw == 1) ret_unit<1, 0, false>(RET_ARGS); else if (ibw == 2) ret_unit<2, 0, false>(RET_ARGS); else ret_unit<3, 0, false>(RET_ARGS); }
                    else { if (ibw == 0) ret_unit<0, 1, false>(RET_ARGS); else if (ibw == 1) ret_unit<1, 1, false>(RET_ARGS); else if (ibw == 2) ret_unit<2, 1, false>(RET_ARGS); else ret_unit<3, 1, false>(RET_ARGS); } } }
            else { pg8::Gemm g{xb, Win + (size_t)4096 * D, M, 2048, D, D}; pg8::StaticOrder S; S.init(M, 2048, G, bid);
                EpiRetG E{ssq, (const float*)(ws + OFF_HSSQ), (bf16_t*)(ws + OFF_RVO)}; if (EN(5)) pg8::gemm_phase(lds, g, S, E, tid); }
        } else {
            const bf16_t* Win = (const bf16_t*)(ws + OFF_WNSA + (size_t)j * NSA_SZ);
            if (gk == 10) { pg8::Gemm g{xb, Win, M, NSA_NPAD, D, D}; pg8::StaticOrder S; S.init(M, NSA_NPAD, G, bid);
                EpiNsaIn E{ssq, pin(P, I_QG) + j * 64, pin(P, I_KG) + j * 192, (bf16_t*)(ws + OFF_NQ), (bf16_t*)(ws + OFF_NKV), (float*)(ws + OFF_NGATE)}; if (EN(6)) pg8::gemm_phase(lds, g, S, E, tid); }
            else if (gk == 11) {
                for (int idx = 0; idx < 8; ++idx) { const int jj = idx & 1, ks = idx >> 1;
                    pg8::Gemm g{(const bf16_t*)(ws + OFF_NKV) + (size_t)jj * KVSEC + ks * 512, Win + (NSAIN_SZ + NSAOUT_SZ + (size_t)jj * NSAW1_SZ) / 2 + ks * 512, 8192, 256, 512, 1024, 2048};
                    pg8::StaticOrder S; S.init(8192, 256, G, (bid + idx * (G / 8)) % G);
                    EpiCmp1 E{(float*)(ob + OB_PART) + (size_t)idx * 8192 * 256}; if (EN(7)) pg8::gemm_phase(lds, g, S, E, tid); }
            }
            else if (gk == 12) { if (EN(8)) cmp2_phase(P, j, tid, ws, ob, bid, G, lds); }
            else { int prev_g = -1; if (tid >= 256) __builtin_amdgcn_s_setprio(1);
                if (EN(9)) for (int u = bid; u < 2048; u += G) { int rnd = u >> 8, sub = (u >> 6) & 3, qt = 31 - 4 * rnd - ((rnd & 1) ? 3 - sub : sub), bg = u & 63;
                if (G == 256) { const int slot = bid >> 3, a = (slot + 8 * (rnd >> 1)) & 31; bg = rnd * 8 + (bid & 7); qt = (rnd & 1) ? 31 - a : a; }
                nsa_unit(lds, P, ws, bg >> 2, bg & 3, qt, tid, (bg & 3) != prev_g); prev_g = bg & 3; }
                __builtin_amdgcn_s_setprio(0); }
        }
        if (ph + 1 < P.ph_hi) { if (ph == 0) cg::this_grid().sync(); else { XcdBarrier xbar; xbar.bar = (unsigned*)(ws + OFF_CTL); xbar.x = xb_xcc_id(); xbar.st = (volatile LAS unsigned*)(lds + LDS_BARST); xcd_barrier(xbar); } }
    }
}

extern "C" void kernel_launch(void* const* d_in, const int* in_sizes, int n_in, void* d_out, int out_size, void* d_ws, size_t ws_size, hipStream_t stream) {
    static int grid = 0;
    if (grid == 0) {
        if (n_in != 18 || out_size != M * D || ws_size < WS_NEED) { fprintf(stderr, "kernel_launch: unexpected shapes n_in %d out %d ws %zu\n", n_in, out_size, ws_size); grid = -1; return; }
        int dev = 0, cus = 0, per_cu = 0;
        hipGetDevice(&dev); hipDeviceGetAttribute(&cus, hipDeviceAttributeMultiprocessorCount, dev);
        hipFuncSetAttribute((const void*)fwd_kernel, hipFuncAttributeMaxDynamicSharedMemorySize, LDS_BYTES);
        hipOccupancyMaxActiveBlocksPerMultiprocessor(&per_cu, (const void*)fwd_kernel, NTHR, LDS_BYTES);
        if (per_cu < 1) per_cu = 1;
        grid = cus * per_cu;
        (void)hipGetLastError();
    }
    if (grid < 0) return;
    Params p{};
    for (int i = 0; i < 18; ++i) p.in[i] = (const float*)d_in[i];
    p.out = (float*)d_out; p.ws = (unsigned char*)d_ws;
    (void)hipMemsetAsync((char*)d_ws + OFF_CTL, 0, CTL_BYTES, stream);
#if MK_ONE_LAUNCH
    p.ph_lo = 0; p.ph_hi = NPHASE;
    void* args[] = {&p};
    hipError_t e = hipLaunchCooperativeKernel((const void*)fwd_kernel, dim3(grid), dim3(NTHR), args, LDS_BYTES, stream);
    if (e != hipSuccess) fprintf(stderr, "cooperative launch failed: %s (grid %d)\n", hipGetErrorString(e), grid);
#else
    for (int ph = 0; ph < NPHASE; ++ph) { p.ph_lo = ph; p.ph_hi = ph + 1; hipLaunchKernelGGL(fwd_kernel, dim3(grid), dim3(NTHR), LDS_BYTES, stream, p); }
#endif
}
```
